# Optimizing an MI355X kernel written in HIP

```python
import math, functools
import jax, jax.numpy as jnp
from jax import lax
import numpy as np

D_MODEL = 2048
BATCH = 1
SEQ = 8192
DEPTH = 1
DEC_BATCH = 128
DEC_SEQ = 4
PAST_LEN = 16384
PAGE_SIZE = 128

ATT_HEADS = 16
ATT_KV_HEADS = 4
ATT_HEAD_DIM = 64
ATT_GROUP = ATT_HEADS // ATT_KV_HEADS
WINDOW = 128
ROPE_THETA = 500000.0
ROPE_DIM = ATT_HEAD_DIM // 4
MLSTM_HEADS = 4
MLSTM_HEAD_DIM = 256
MLSTM_CHUNK = 64
FGATE_BIAS_LO = 3.0
FGATE_BIAS_HI = 6.0
ATT_WIDTH = ATT_HEADS * ATT_HEAD_DIM
KV_WIDTH = ATT_KV_HEADS * ATT_HEAD_DIM
MLSTM_WIDTH = MLSTM_HEADS * MLSTM_HEAD_DIM
MIX_WIDTH = ATT_WIDTH + MLSTM_WIDTH
IN_WIDTH = ATT_WIDTH + 2 * KV_WIDTH + 4 * MLSTM_WIDTH + 2 * MLSTM_HEADS
D_FF = ((8 * D_MODEL // 3 + 255) // 256) * 256
N_MOD = 6
EPS = 1e-6

kernel_name = 'hymba_mlstm_swa_sink_decoder_step'


def rmsnorm(x, w):
    xf = x.astype(jnp.float32)
    y = xf * lax.rsqrt(jnp.mean(xf * xf, axis=-1, keepdims=True) + EPS)
    return (y * w.astype(jnp.float32)).astype(x.dtype)


def partial_rope(x, pos):
    half = ROPE_DIM // 2
    inv = ROPE_THETA ** (-jnp.arange(0, ROPE_DIM, 2, dtype=jnp.float32) / ROPE_DIM)
    ang = pos.astype(jnp.float32)[:, None] * inv[None, :]
    cos = jnp.cos(ang)[None, :, None, :]
    sin = jnp.sin(ang)[None, :, None, :]
    xr = x[..., :ROPE_DIM].astype(jnp.float32)
    x1, x2 = xr[..., :half], xr[..., half:]
    rot = jnp.concatenate([x1 * cos - x2 * sin, x2 * cos + x1 * sin], axis=-1)
    return jnp.concatenate([rot.astype(x.dtype), x[..., ROPE_DIM:]], axis=-1)


def sink_attention(q, k, v, allowed, sinks):
    s = jnp.einsum('bnqhgd,bnkhd->bnhgqk', q, k).astype(jnp.float32) * (ATT_HEAD_DIM ** -0.5)
    s = jnp.where(allowed[None, :, None, None], s, -jnp.inf)
    sink = jnp.broadcast_to(sinks.astype(jnp.float32).reshape(1, 1, ATT_KV_HEADS, ATT_GROUP, 1, 1),
                            s.shape[:-1] + (1,))
    p = jax.nn.softmax(jnp.concatenate([s, sink], axis=-1), axis=-1)[..., :-1]
    return jnp.einsum('bnhgqk,bnkhd->bnqhgd', p.astype(v.dtype), v)


def swa_prompt(q, k, v, sinks):
    B, S = q.shape[0], q.shape[1]
    nb = S // WINDOW
    qb = q.reshape(B, nb, WINDOW, ATT_KV_HEADS, ATT_GROUP, ATT_HEAD_DIM)
    pad = jnp.zeros((B, WINDOW, ATT_KV_HEADS, ATT_HEAD_DIM), k.dtype)
    kp = jnp.concatenate([pad, k], axis=1).reshape(B, nb + 1, WINDOW, ATT_KV_HEADS, ATT_HEAD_DIM)
    vp = jnp.concatenate([pad.astype(v.dtype), v], axis=1).reshape(B, nb + 1, WINDOW, ATT_KV_HEADS, ATT_HEAD_DIM)
    kb = jnp.concatenate([kp[:, :-1], kp[:, 1:]], axis=2)
    vb = jnp.concatenate([vp[:, :-1], vp[:, 1:]], axis=2)
    qi = jnp.arange(WINDOW)[:, None]
    kj = jnp.arange(2 * WINDOW)[None, :]
    diff = qi + WINDOW - kj
    key_pos = jnp.arange(nb)[:, None, None] * WINDOW - WINDOW + kj[None]
    allowed = ((diff >= 0) & (diff < WINDOW))[None] & (key_pos >= 0)
    o = sink_attention(qb, kb, vb, allowed, sinks)
    return o.reshape(B, S, ATT_WIDTH), k[:, S - WINDOW:], v[:, S - WINDOW:]


def swa_sample(q, k, v, k_buf, v_buf, sinks):
    B, T = q.shape[0], q.shape[1]
    kk = jnp.concatenate([k_buf.astype(k.dtype), k], axis=1)
    vv = jnp.concatenate([v_buf.astype(v.dtype), v], axis=1)
    qi = jnp.arange(T)[:, None]
    kj = jnp.arange(WINDOW + T)[None, :]
    diff = qi + WINDOW - kj
    allowed = ((diff >= 0) & (diff < WINDOW))[None]
    o = sink_attention(q.reshape(B, 1, T, ATT_KV_HEADS, ATT_GROUP, ATT_HEAD_DIM),
                       kk[:, None], vv[:, None], allowed, sinks)
    return o.reshape(B, T, ATT_WIDTH), kk[:, T:], vv[:, T:]


def mlstm(q, k, v, ig, fg, C0, n0, m0):
    B, S, H, DH = q.shape
    L = math.gcd(S, MLSTM_CHUNK)
    nc = S // L
    f32 = jnp.float32

    def chunks(a):
        return jnp.transpose(a.astype(f32).reshape(B, nc, L, H, DH), (1, 0, 3, 2, 4))

    def gchunks(a):
        return jnp.transpose(a.astype(f32).reshape(B, nc, L, H), (1, 0, 3, 2))

    qc = chunks(q) * (DH ** -0.5)
    kc, vc = chunks(k), chunks(v)
    li = gchunks(ig)
    lf = jax.nn.log_sigmoid(gchunks(fg))
    causal = jnp.tril(jnp.ones((L, L), dtype=bool))

    def step(carry, xs):
        C, n, m = carry
        qt, kt, vt, lit, lft = xs
        b = jnp.cumsum(lft, axis=-1)
        dm = jnp.where(causal, b[..., :, None] - b[..., None, :] + lit[..., None, :], -jnp.inf)
        m_inter = b + m[..., None]
        m_t = jnp.maximum(m_inter, jnp.max(dm, axis=-1))
        sm = jnp.einsum('bhtd,bhsd->bhts', qt, kt) * jnp.exp(dm - m_t[..., None])
        a = jnp.exp(m_inter - m_t)
        num = a[..., None] * jnp.einsum('bhtd,bhvd->bhtv', qt, C) + jnp.einsum('bhts,bhsv->bhtv', sm, vt)
        den = a * jnp.einsum('bhtd,bhd->bht', qt, n) + jnp.sum(sm, axis=-1)
        h = num / jnp.maximum(jnp.abs(den), jnp.exp(-m_t))[..., None]
        m_new = m_t[..., -1]
        g = jnp.exp(b[..., -1:] - b + lit - m_new[..., None])
        decay = jnp.exp(b[..., -1] + m - m_new)
        C_new = decay[..., None, None] * C + jnp.einsum('bhs,bhsv,bhsd->bhvd', g, vt, kt)
        n_new = decay[..., None] * n + jnp.einsum('bhs,bhsd->bhd', g, kt)
        return (C_new, n_new, m_new), h

    (C, n, m), hs = lax.scan(step, (C0.astype(f32), n0.astype(f32), m0.astype(f32)), (qc, kc, vc, li, lf))
    h = jnp.transpose(hs, (1, 0, 3, 2, 4)).reshape(B, S, H, DH)
    return h.astype(q.dtype), C, n, m


def trunk_layer(x, c, pos, attn_fn, C0, n0, m0, norm1_w, norm2_w, w_ada, b_ada, w_in, b_ig, b_fg,
                mh_norm_w, w_out, w_gate, w_up, w_down):
    B, S = x.shape[0], x.shape[1]
    mod = (jax.nn.silu(c) @ w_ada + b_ada)[:, None, :]
    sh1, sc1, g1, sh2, sc2, g2 = jnp.split(mod, N_MOD, axis=-1)
    h = rmsnorm(x, norm1_w) * (1 + sc1) + sh1
    p = h @ w_in
    cuts = [int(s) for s in np.cumsum([ATT_WIDTH, KV_WIDTH, KV_WIDTH, MLSTM_WIDTH, MLSTM_WIDTH,
                                       MLSTM_WIDTH, MLSTM_WIDTH, MLSTM_HEADS])]
    aq, ak, av, mq, mk, mv, mo, mi, mf = jnp.split(p, cuts, axis=-1)
    aq = partial_rope(aq.reshape(B, S, ATT_HEADS, ATT_HEAD_DIM), pos)
    ak = partial_rope(ak.reshape(B, S, ATT_KV_HEADS, ATT_HEAD_DIM), pos)
    av = av.reshape(B, S, ATT_KV_HEADS, ATT_HEAD_DIM)
    att_o, k_state, v_state = attn_fn(aq, ak, av)
    mshape = (B, S, MLSTM_HEADS, MLSTM_HEAD_DIM)
    mh, C, n, m = mlstm(mq.reshape(mshape), mk.reshape(mshape), mv.reshape(mshape),
                        mi + b_ig, mf + b_fg, C0, n0, m0)
    mh = rmsnorm(mh, mh_norm_w.reshape(MLSTM_HEADS, MLSTM_HEAD_DIM)).reshape(B, S, MLSTM_WIDTH) * jax.nn.sigmoid(mo)
    x = x + g1 * (jnp.concatenate([att_o, mh], axis=-1) @ w_out)
    h = rmsnorm(x, norm2_w) * (1 + sc2) + sh2
    x = x + g2 * ((jax.nn.silu(h @ w_gate) * (h @ w_up)) @ w_down)
    return x, k_state, v_state, C, n, m


def setup_inputs(seed: int = 0) -> dict:
    key = jax.random.key(seed)
    ks = jax.random.split(key, 24)
    f32 = jnp.float32

    def nrm(k, shape, scale):
        return jax.random.normal(k, shape, f32) * scale

    return {
        'x_prompt': nrm(ks[0], (BATCH, SEQ, D_MODEL), 1.0),
        'x_sample': nrm(ks[1], (DEC_BATCH, DEC_SEQ, D_MODEL), 1.0),
        'cache_k_win': nrm(ks[2], (DEPTH, DEC_BATCH, WINDOW, ATT_KV_HEADS, ATT_HEAD_DIM), 1.0),
        'cache_v_win': nrm(ks[3], (DEPTH, DEC_BATCH, WINDOW, ATT_KV_HEADS, ATT_HEAD_DIM), 1.0),
        'state_C': nrm(ks[4], (DEPTH, DEC_BATCH, MLSTM_HEADS, MLSTM_HEAD_DIM, MLSTM_HEAD_DIM), 0.1),
        'state_n': nrm(ks[5], (DEPTH, DEC_BATCH, MLSTM_HEADS, MLSTM_HEAD_DIM), 0.5),
        'state_m': nrm(ks[6], (DEPTH, DEC_BATCH, MLSTM_HEADS), 1.0),
        'c_prompt': nrm(ks[7], (BATCH, D_MODEL), 1.0),
        'c_sample': nrm(ks[8], (DEC_BATCH, D_MODEL), 1.0),
        'norm1_w': 1.0 + nrm(ks[9], (DEPTH, D_MODEL), 0.02),
        'norm2_w': 1.0 + nrm(ks[10], (DEPTH, D_MODEL), 0.02),
        'final_norm_w': 1.0 + nrm(ks[11], (D_MODEL,), 0.02),
        'w_ada': nrm(ks[12], (DEPTH, D_MODEL, N_MOD * D_MODEL), 0.5 * D_MODEL ** -0.5),
        'b_ada': nrm(ks[13], (DEPTH, N_MOD * D_MODEL), 0.02),
        'w_in': nrm(ks[14], (DEPTH, D_MODEL, IN_WIDTH), D_MODEL ** -0.5),
        'b_ig': nrm(ks[15], (DEPTH, MLSTM_HEADS), 0.1),
        'b_fg': jnp.linspace(FGATE_BIAS_LO, FGATE_BIAS_HI, MLSTM_HEADS, dtype=f32)[None, :] + nrm(ks[16], (DEPTH, MLSTM_HEADS), 0.1),
        'attn_sinks': nrm(ks[17], (DEPTH, ATT_HEADS), 0.5),
        'mh_norm_w': 1.0 + nrm(ks[18], (DEPTH, MLSTM_WIDTH), 0.02),
        'w_out': nrm(ks[19], (DEPTH, MIX_WIDTH, D_MODEL), MIX_WIDTH ** -0.5),
        'w_gate': nrm(ks[20], (DEPTH, D_MODEL, D_FF), D_MODEL ** -0.5),
        'w_up': nrm(ks[21], (DEPTH, D_MODEL, D_FF), D_MODEL ** -0.5),
        'w_down': nrm(ks[22], (DEPTH, D_FF, D_MODEL), D_FF ** -0.5),
    }


def reference(x_prompt, x_sample, cache_k_win, cache_v_win, state_C, state_n, state_m, c_prompt, c_sample,
              norm1_w, norm2_w, final_norm_w, w_ada, b_ada, w_in, b_ig, b_fg, attn_sinks, mh_norm_w,
              w_out, w_gate, w_up, w_down):
    f32 = jnp.float32
    pos_p = jnp.arange(SEQ, dtype=jnp.int32)
    pos_s = PAST_LEN + jnp.arange(DEC_SEQ, dtype=jnp.int32)
    C0 = jnp.zeros((BATCH, MLSTM_HEADS, MLSTM_HEAD_DIM, MLSTM_HEAD_DIM), f32)
    n0 = jnp.zeros((BATCH, MLSTM_HEADS, MLSTM_HEAD_DIM), f32)
    m0 = jnp.zeros((BATCH, MLSTM_HEADS), f32)
    xp, xs = x_prompt, x_sample
    kp_l, vp_l, Cp_l, np_l, mp_l = [], [], [], [], []
    ks_l, vs_l, Cs_l, ns_l, ms_l = [], [], [], [], []
    for l in range(DEPTH):
        shared = (norm1_w[l], norm2_w[l], w_ada[l], b_ada[l], w_in[l], b_ig[l], b_fg[l],
                  mh_norm_w[l], w_out[l], w_gate[l], w_up[l], w_down[l])
        attn_p = functools.partial(swa_prompt, sinks=attn_sinks[l])
        attn_s = functools.partial(swa_sample, k_buf=cache_k_win[l], v_buf=cache_v_win[l], sinks=attn_sinks[l])
        xp, kp, vp, Cp, npr, mp = trunk_layer(xp, c_prompt, pos_p, attn_p, C0, n0, m0, *shared)
        xs, ksm, vsm, Cs, ns, ms = trunk_layer(xs, c_sample, pos_s, attn_s,
                                               state_C[l], state_n[l], state_m[l], *shared)
        kp_l.append(kp); vp_l.append(vp); Cp_l.append(Cp); np_l.append(npr); mp_l.append(mp)
        ks_l.append(ksm); vs_l.append(vsm); Cs_l.append(Cs); ns_l.append(ns); ms_l.append(ms)
    y_prompt = rmsnorm(xp, final_norm_w)
    y_sample = rmsnorm(xs, final_norm_w)
    return (y_prompt, y_sample,
            jnp.stack(kp_l), jnp.stack(vp_l), jnp.stack(Cp_l), jnp.stack(np_l), jnp.stack(mp_l),
            jnp.stack(ks_l), jnp.stack(vs_l), jnp.stack(Cs_l), jnp.stack(ns_l), jnp.stack(ms_l))
```

```cpp
#include <hip/hip_runtime.h>
#include <hip/hip_cooperative_groups.h>
#include <cstdio>
#include <cstdint>
namespace cg = cooperative_groups;

#define LAS __attribute__((address_space(3)))
typedef unsigned short bf16_t;
typedef short bf16x8 __attribute__((ext_vector_type(8)));
typedef float f32x4 __attribute__((ext_vector_type(4)));
typedef unsigned u32x4 __attribute__((ext_vector_type(4)));
typedef unsigned u32x2 __attribute__((ext_vector_type(2)));

constexpr int D = 2048, SP = 8192, NB = 128, TS = 4, MS = NB * TS, MTOT = SP + MS;
constexpr int NIN = 5632, INW = 5640, DFF = 5632, NMOD = 12288;
constexpr int C_AQ = 0, C_AK = 1024, C_AV = 1280, C_MQ = 1536, C_MK = 2560, C_MV = 3584, C_MO = 4608;
constexpr float EPS = 1e-6f;
constexpr int LC = 256, NCH = SP / LC;

constexpr size_t al256(size_t x) { return (x + 255) & ~(size_t)255; }
constexpr size_t WS_WADA = 0;
constexpr size_t WS_WIN = WS_WADA + (size_t)NMOD * D * 2;
constexpr size_t WS_WOUT = WS_WIN + (size_t)NIN * D * 2;
constexpr size_t WS_WGU = WS_WOUT + (size_t)D * D * 2;
constexpr size_t WS_WDN = WS_WGU + (size_t)2 * DFF * D * 2;
constexpr size_t WS_SILU = WS_WDN + (size_t)D * DFF * 2;
constexpr size_t WS_MOD = WS_SILU + (size_t)256 * D * 2;
constexpr size_t WS_H = al256(WS_MOD + (size_t)129 * NMOD * 4);
constexpr size_t WS_GATES = WS_H + (size_t)MTOT * D * 2;
constexpr size_t WS_P = al256(WS_GATES + (size_t)MTOT * 8 * 4);
constexpr size_t WS_MIX = WS_P + (size_t)MTOT * NIN * 2;
constexpr size_t WS_X1 = WS_MIX + (size_t)MTOT * D * 2;
constexpr size_t WS_ROPE = WS_X1 + (size_t)MTOT * D * 4;
constexpr size_t WS_WG = al256(WS_ROPE + (size_t)8196 * 16 * 4);
constexpr size_t WS_BC = WS_WG + (size_t)8 * D * 4;
constexpr size_t WS_BW = WS_BC + (size_t)4 * SP * 4;
constexpr size_t WS_MR = WS_BW + (size_t)4 * SP * 4;
constexpr size_t WS_U = WS_MR + (size_t)4 * SP * 4;
constexpr size_t WS_UN = WS_U + (size_t)NCH * 4 * 65536 * 4;
constexpr size_t WS_CST = WS_UN + (size_t)NCH * 4 * 256 * 4;
constexpr size_t WS_NST = WS_CST + (size_t)NCH * 4 * 65536 * 2;
constexpr size_t WS_PART = WS_NST + (size_t)NCH * 4 * 256 * 4;
constexpr size_t WS_BAR = WS_PART + (size_t)11 * MS * D * 4;
constexpr size_t WS_SSQ = WS_BAR + 16384;
constexpr size_t WS_END = WS_SSQ + (size_t)256 * 256 * 4;
constexpr size_t WS_PCNT = WS_BAR + 14336;

constexpr size_t O_Y = 0;
constexpr size_t O_KWP = (size_t)MTOT * D;
constexpr size_t O_VWP = O_KWP + 32768;
constexpr size_t O_CP = O_VWP + 32768;
constexpr size_t O_NP = O_CP + 262144;
constexpr size_t O_MP = O_NP + 1024;
constexpr size_t O_KWS = O_MP + 4;
constexpr size_t O_VWS = O_KWS + (size_t)NB * 128 * 256;
constexpr size_t O_CS = O_VWS + (size_t)NB * 128 * 256;
constexpr size_t O_NS = O_CS + (size_t)NB * 4 * 65536;
constexpr size_t O_MS = O_NS + (size_t)NB * 4 * 256;
constexpr size_t O_END = O_MS + (size_t)NB * 4;

constexpr int LDS_BYTES = 147456;
constexpr int NPHASE = 12;

struct Params { const float* in[23]; float* out; unsigned char* ws; int ph_lo, ph_hi, p4m, pad; };

__device__ __forceinline__ unsigned cvt_pk_bf16(float lo, float hi) { unsigned r; asm volatile("v_cvt_pk_bf16_f32 %0, %1, %2" : "=v"(r) : "v"(lo), "v"(hi)); return r; }
__device__ __forceinline__ float bf_lo(unsigned u) { return __uint_as_float(u << 16); }
__device__ __forceinline__ float bf_hi(unsigned u) { return __uint_as_float(u & 0xffff0000u); }
__device__ __forceinline__ float bf2f(bf16_t h) { return __uint_as_float((unsigned)h << 16); }
__device__ __forceinline__ float wave_sum(float v) {
#pragma unroll
    for (int o = 32; o >= 1; o >>= 1) v += __shfl_xor(v, o);
    return v;
}
__device__ __forceinline__ float wave_max(float v) {
#pragma unroll
    for (int o = 32; o >= 1; o >>= 1) v = fmaxf(v, __shfl_xor(v, o));
    return v;
}
__device__ __forceinline__ void lds_add(LAS float* p, float v) { __hip_atomic_fetch_add(p, v, __ATOMIC_RELAXED, __HIP_MEMORY_SCOPE_WORKGROUP); }
__device__ __forceinline__ float sigmoidf_(float x) { return 1.f / (1.f + __expf(-x)); }
__device__ __forceinline__ float logsigmoid_(float x) { return fminf(x, 0.f) - log1pf(expf(-fabsf(x))); }
__device__ __forceinline__ float logsigmoid_fast(float x) { return fminf(x, 0.f) - __logf(1.f + __expf(-fabsf(x))); }
__device__ __forceinline__ void unpack8(const u32x4 v, float (&f)[8]) {
    f[0] = bf_lo(v.x); f[1] = bf_hi(v.x); f[2] = bf_lo(v.y); f[3] = bf_hi(v.y); f[4] = bf_lo(v.z); f[5] = bf_hi(v.z); f[6] = bf_lo(v.w); f[7] = bf_hi(v.w);
}
__device__ __forceinline__ u32x4 pack8(const float (&f)[8]) {
    u32x4 r; r.x = cvt_pk_bf16(f[0], f[1]); r.y = cvt_pk_bf16(f[2], f[3]); r.z = cvt_pk_bf16(f[4], f[5]); r.w = cvt_pk_bf16(f[6], f[7]); return r;
}
__device__ __forceinline__ void zip8(const u32x4 a, const u32x4 b, unsigned (&w)[8]) {
    w[0] = (a.x & 0xffffu) | (b.x << 16); w[1] = (a.x >> 16) | (b.x & 0xffff0000u); w[2] = (a.y & 0xffffu) | (b.y << 16); w[3] = (a.y >> 16) | (b.y & 0xffff0000u);
    w[4] = (a.z & 0xffffu) | (b.z << 16); w[5] = (a.z >> 16) | (b.z & 0xffff0000u); w[6] = (a.w & 0xffffu) | (b.w << 16); w[7] = (a.w >> 16) | (b.w & 0xffff0000u);
}
__device__ __forceinline__ void rope8(float (&own)[8], const float (&oth)[8], const float* cs, int dg) {
#pragma unroll
    for (int i = 0; i < 8; ++i) { const float c = cs[i], s = cs[8 + i]; own[i] = (dg == 0) ? own[i] * c - oth[i] * s : own[i] * c + oth[i] * s; }
}

#define XB_TMO      128
#define XB_XCNT(j)  (256  + 64 * (j))
#define XB_XSUB(j)  (1280 + 64 * (j))
#define XB_XGEN(j)  (2304 + 64 * (j))
#define XB_TOP      3328
#define XB_TOPGEN   3392
#define XCD_BAR_WORDS 3456
#define XB_SPIN_CAP (1u << 18)

__device__ __forceinline__ unsigned xb_ld(unsigned* p)              { return __hip_atomic_load(p, __ATOMIC_RELAXED, __HIP_MEMORY_SCOPE_AGENT); }
__device__ __forceinline__ unsigned xb_add(unsigned* p, unsigned v) { return __hip_atomic_fetch_add(p, v, __ATOMIC_RELAXED, __HIP_MEMORY_SCOPE_AGENT); }
__device__ __forceinline__ unsigned xb_xcc_id() { return (unsigned)__builtin_amdgcn_s_getreg((3 << 11) | 20) & 0xFu; }
#define XB_SPIN(cond, bar) do { unsigned _sp = 0; while (cond) { __builtin_amdgcn_s_sleep(1); \
    if ((++_sp & 255u) == 0u) { if (xb_ld(&(bar)[XB_TMO])) break; if (_sp > XB_SPIN_CAP) { (void)xb_add(&(bar)[XB_TMO], 1u); break; } } } } while (0)

struct XcdBarrier {
    unsigned* bar; unsigned x;
    volatile LAS unsigned* st;
};

__device__ __forceinline__ XcdBarrier xcd_barrier_post(unsigned* bar, volatile LAS unsigned* st) {
    XcdBarrier b; b.bar = bar; b.x = xb_xcc_id(); b.st = st;
    if (threadIdx.x == 0) (void)xb_add(&bar[XB_XCNT(b.x)], 1u);
    return b;
}
__device__ __forceinline__ void xcd_barrier_complete(unsigned* bar, unsigned x, unsigned& nloc, unsigned& nx) {
    const unsigned G = gridDim.x * gridDim.y * gridDim.z;
    unsigned sum, cnt, mine, sp = 0u;
    for (;;) {
        sum = 0u; cnt = 0u; mine = 0u;
#pragma unroll
        for (unsigned j = 0; j < 16; ++j) { const unsigned c = xb_ld(&bar[XB_XCNT(j)]); sum += c; cnt += (c > 0u) ? 1u : 0u; mine = (j == x) ? c : mine; }
        if (sum == G) break;
        __builtin_amdgcn_s_sleep(1);
        if ((++sp & 255u) == 0u) { if (xb_ld(&bar[XB_TMO])) break; if (sp > XB_SPIN_CAP) { (void)xb_add(&bar[XB_TMO], 1u); break; } }
    }
    nloc = mine > 0u ? mine : 1u; nx = cnt > 0u ? cnt : 1u;
}

__device__ __forceinline__ void xcd_barrier(const XcdBarrier& b) {
    asm volatile("s_waitcnt vmcnt(0)" ::: "memory");
    __syncthreads();
    if (threadIdx.x == 0) {
        unsigned* bar = b.bar;
        __builtin_amdgcn_s_waitcnt(0);
        unsigned nloc = b.st[0], nx = b.st[1];
        if (nloc == 0u) { xcd_barrier_complete(bar, b.x, nloc, nx); b.st[0] = nloc; b.st[1] = nx; }
        const unsigned old = xb_add(&bar[XB_XSUB(b.x)], 1u);
        const unsigned gen = old / nloc;
        if (old + 1u == (gen + 1u) * nloc) {
            __builtin_amdgcn_fence(__ATOMIC_RELEASE, "agent");
            asm volatile("s_waitcnt vmcnt(0)" ::: "memory");
            const unsigned og = xb_add(&bar[XB_TOP], 1u);
            const unsigned tg = og / nx;
            if (og + 1u == (tg + 1u) * nx) xb_add(&bar[XB_TOPGEN], 1u);
            else XB_SPIN(xb_ld(&bar[XB_TOPGEN]) == tg, bar);
            __builtin_amdgcn_fence(__ATOMIC_ACQUIRE, "agent");
            xb_add(&bar[XB_XGEN(b.x)], 1u);
            asm volatile("s_waitcnt vmcnt(0)" ::: "memory");
        } else {
            XB_SPIN(xb_ld(&bar[XB_XGEN(b.x)]) == gen, bar);
            __builtin_amdgcn_fence(__ATOMIC_ACQUIRE, "agent");
            asm volatile("s_waitcnt vmcnt(0)" ::: "memory");
        }
    }
    __syncthreads();
}


__device__ __forceinline__ void grid_bar(unsigned* ctr, unsigned target) {
    __syncthreads();
    if (threadIdx.x == 0) {
        __builtin_amdgcn_fence(__ATOMIC_RELEASE, "agent");
        __hip_atomic_fetch_add(ctr, 1u, __ATOMIC_RELAXED, __HIP_MEMORY_SCOPE_AGENT);
        while (__hip_atomic_load(ctr, __ATOMIC_RELAXED, __HIP_MEMORY_SCOPE_AGENT) < target) __builtin_amdgcn_s_sleep(2);
        __builtin_amdgcn_fence(__ATOMIC_ACQUIRE, "agent");
    }
    __syncthreads();
}

namespace pg8 {
constexpr int BM = 256, BK = 64, HALF = 128, HTB = HALF * BK * 2, STAGE_BYTES = 8 * HTB, NXCD = 8, WGM = 8;
__host__ __device__ __forceinline__ int lds_byte(int r, int c) { const int st = (r >> 4) * 2 + (c >> 5), rr = r & 15, cc = c & 31, ob = rr * 64 + cc * 2; return st * 1024 + (ob ^ (((ob >> 9) & 1) << 5)); }
__host__ __device__ __forceinline__ void stage_rc(int b, int& R, int& C) { const int st = b / 1024, sb = b % 1024, swz = sb ^ (((sb >> 9) & 1) << 5); R = (st >> 1) * 16 + swz / 64; C = (st & 1) * 32 + (swz % 64) / 2; }
__host__ __device__ __forceinline__ int perm32(int rho) { const int n = rho >> 4, i = rho & 15; return 8 * (i >> 2) + 4 * n + (i & 3); }
struct Unit { int pm, pn, kz, nt; };
struct Gemm { const bf16_t* A; const bf16_t* Bt; int lda, ldb; };
struct StaticOrder {
    int nM, nN, nwg, G, c, nt;
    __device__ void init(int M, int N, int G_, int c_, int nt_) { nM = M / BM; nN = N / BM; nwg = nM * nN; G = G_; c = c_; nt = nt_; }
    __device__ bool next(int i, Unit& u) const {
        const long L = (long)i * G + c; if (L >= nwg) return false;
        int wgid = (int)L; { const int q = nwg / NXCD, r = nwg % NXCD, xcd = wgid % NXCD, off = wgid / NXCD; wgid = (xcd < r ? xcd * (q + 1) : r * (q + 1) + (xcd - r) * q) + off; }
        const int nig = WGM * nN, gid = wgid / nig, fm = gid * WGM, gsz = (nM - fm) < WGM ? (nM - fm) : WGM;
        u.pm = fm + ((wgid % nig) % gsz); u.pn = (wgid % nig) / gsz; u.kz = 0; u.nt = nt; return true;
    }
};
struct SplitKOrder {
    int nN, nz, G, c, nt;
    __device__ bool next(int i, Unit& u) const { const int L = i * G + c; if (L >= nN * nz) return false; u.pm = 0; u.pn = L % nN; u.kz = L / nN; u.nt = nt; return true; }
};
struct PromptSampleOrder {
    int G, c, ntfull, nz;
    __device__ bool next(int i, Unit& u) const {
        const int L = i * G + c; if (L >= 256 + 16 * nz) return false;
        if (L < 256) { int wgid = L; { const int q = 256 / NXCD, xcd = wgid % NXCD, off = wgid / NXCD; wgid = xcd * q + off; }
            const int nig = WGM * 8, gid = wgid / nig, fm = gid * WGM; u.pm = fm + ((wgid % nig) % WGM); u.pn = (wgid % nig) / WGM; u.kz = 0; u.nt = ntfull; }
        else { const int idx = L - 256; u.pn = idx & 7; u.pm = 32 + ((idx >> 3) & 1); u.kz = idx >> 4; u.nt = ntfull / nz; }
        return true; }
};

template <class Epi, class Sched>
__device__ __forceinline__ void gemm_phase(LAS unsigned char* lds, const Gemm g, const Sched& S, const Epi& E) {
    const int tid = threadIdx.x, wid = __builtin_amdgcn_readfirstlane(tid >> 6), lane = tid & 63, wr = wid >> 2, wc = wid & 3, fr = lane & 15, fq = lane >> 4;
    unsigned voffA[2], voffB[2];
#pragma unroll
    for (int i = 0; i < 2; ++i) { int R, C; stage_rc(tid * 16 + i * 8192, R, C); const int Rb = Epi::PERM ? ((R & ~31) + perm32(R & 31)) : R;
        voffA[i] = (unsigned)(R * g.lda + C) * 2u; voffB[i] = (unsigned)(Rb * g.ldb + C) * 2u; }
    const size_t kstep = (size_t)(BK * 2);
    const size_t hstepA = (size_t)HALF * g.lda * 2, hstepB = (size_t)HALF * g.ldb * 2;
    const size_t tstepA = 2 * hstepA, tstepB = 2 * hstepB;
    const unsigned ldsw = (unsigned)wid * 1024u;
    const int aoff = lds_byte(wr * 64 + fr, fq * 8), boff = lds_byte(wc * 32 + fr, fq * 8);
#define PG8_SA(b, h) (((b) * 2 + (h)) * HTB)
#define PG8_SB(b, h) ((4 + (b) * 2 + (h)) * HTB)
#define PG8_STAGE(bufoff, gbase, voff) do { _Pragma("unroll") for (int _i = 0; _i < 2; ++_i) \
        __builtin_amdgcn_global_load_lds((const unsigned*)((const char*)(gbase) + (voff)[_i]), (LAS unsigned*)(lds + (bufoff) + ldsw + _i * 8192), 16, 0, 0); } while (0)
#define PG8_LDA(dst, b, h) do { _Pragma("unroll") for (int m = 0; m < 4; ++m) _Pragma("unroll") for (int k = 0; k < 2; ++k) dst[m][k] = *(const LAS bf16x8*)(lds + PG8_SA(b, h) + aoff + m * 2048 + k * 1024); } while (0)
#define PG8_LDB(dst, b, h) do { _Pragma("unroll") for (int n = 0; n < 2; ++n) _Pragma("unroll") for (int k = 0; k < 2; ++k) dst[n][k] = *(const LAS bf16x8*)(lds + PG8_SB(b, h) + boff + n * 2048 + k * 1024); } while (0)
#define PG8_MMA(ai, bj, At, Bt) do { __builtin_amdgcn_s_setprio(1); _Pragma("unroll") for (int m = 0; m < 4; ++m) _Pragma("unroll") for (int n = 0; n < 2; ++n) _Pragma("unroll") for (int k = 0; k < 2; ++k) \
        acc[ai][bj][m][n] = __builtin_amdgcn_mfma_f32_16x16x32_bf16(Bt[n][k], At[m][k], acc[ai][bj][m][n], 0, 0, 0); __builtin_amdgcn_s_setprio(0); } while (0)
#define PG8_WAIT_V(n) asm volatile("s_waitcnt vmcnt(" #n ")" ::: "memory")
#define PG8_WAIT_L(n) asm volatile("s_waitcnt lgkmcnt(" #n ")" ::: "memory")
#define PG8_BAR __builtin_amdgcn_s_barrier()
#define PG8_SCHED __builtin_amdgcn_sched_barrier(0)
    Unit cur, nxt; int ui = 0;
    if (!S.next(0, cur)) return;
    f32x4 acc[2][2][4][2];
#pragma unroll
    for (int a = 0; a < 2; ++a)
#pragma unroll
        for (int b = 0; b < 2; ++b)
#pragma unroll
            for (int m = 0; m < 4; ++m)
#pragma unroll
                for (int n = 0; n < 2; ++n) acc[a][b][m][n] = (f32x4){0.f, 0.f, 0.f, 0.f};
    bf16x8 At[4][2], B0[2][2], B1[2][2];
    const char* cA = (const char*)g.A + (size_t)cur.pm * tstepA + (size_t)cur.kz * cur.nt * (BK * 2); const char* cB = (const char*)g.Bt + (size_t)cur.pn * tstepB + (size_t)cur.kz * cur.nt * (BK * 2);
    PG8_STAGE(PG8_SB(0, 0), cB, voffB); PG8_STAGE(PG8_SB(0, 1), cB + hstepB, voffB); PG8_STAGE(PG8_SA(0, 0), cA, voffA); PG8_STAGE(PG8_SA(0, 1), cA + hstepA, voffA);
    if (wr == 1) PG8_BAR;
    PG8_WAIT_V(2); PG8_BAR;
    PG8_STAGE(PG8_SB(1, 0), cB + kstep, voffB); PG8_STAGE(PG8_SA(1, 0), cA + kstep, voffA); PG8_STAGE(PG8_SB(1, 1), cB + hstepB + kstep, voffB);
    PG8_WAIT_V(6); PG8_BAR;
    for (;;) {
        const bool has_next = S.next(ui + 1, nxt);
        const char* nA = has_next ? (const char*)g.A + (size_t)nxt.pm * tstepA + (size_t)nxt.kz * nxt.nt * (BK * 2) : cA; const char* nB = has_next ? (const char*)g.Bt + (size_t)nxt.pn * tstepB + (size_t)nxt.kz * nxt.nt * (BK * 2) : cB;
        const int nt = cur.nt;
        for (int t = 0; t < nt; t += 2) {
            const bool last = (t == nt - 2);
            const char* a1 = cA + (size_t)(t + 1) * kstep;
            const char* a2 = last ? nA : cA + (size_t)(t + 2) * kstep; const char* b2 = last ? nB : cB + (size_t)(t + 2) * kstep;
            const char* a3 = a2 + kstep; const char* b3 = b2 + kstep;
            PG8_LDB(B0, 0, 0); PG8_LDB(B1, 0, 1); PG8_SCHED; PG8_LDA(At, 0, 0); PG8_STAGE(PG8_SA(1, 1), a1 + hstepA, voffA);
            PG8_WAIT_V(8); PG8_WAIT_L(0); PG8_BAR; PG8_MMA(0, 0, At, B0); PG8_MMA(0, 1, At, B1); PG8_BAR; PG8_SCHED;
            PG8_LDA(At, 0, 1); PG8_STAGE(PG8_SB(0, 0), b2, voffB); PG8_STAGE(PG8_SB(0, 1), b2 + hstepB, voffB); PG8_STAGE(PG8_SA(0, 0), a2, voffA);
            PG8_WAIT_V(8); PG8_WAIT_L(0); PG8_BAR; PG8_MMA(1, 0, At, B0); PG8_MMA(1, 1, At, B1); PG8_BAR; PG8_SCHED;
            PG8_LDB(B0, 1, 0); PG8_LDB(B1, 1, 1); PG8_SCHED; PG8_LDA(At, 1, 0); PG8_STAGE(PG8_SA(0, 1), a2 + hstepA, voffA);
            PG8_WAIT_V(8); PG8_WAIT_L(0); PG8_BAR; PG8_MMA(0, 0, At, B0); PG8_MMA(0, 1, At, B1); PG8_BAR; PG8_SCHED;
            PG8_LDA(At, 1, 1); PG8_STAGE(PG8_SB(1, 0), b3, voffB); PG8_STAGE(PG8_SB(1, 1), b3 + hstepB, voffB); PG8_STAGE(PG8_SA(1, 0), a3, voffA);
            PG8_WAIT_V(8); PG8_WAIT_L(0); PG8_BAR; PG8_MMA(1, 0, At, B0); PG8_MMA(1, 1, At, B1); PG8_BAR; PG8_SCHED;
        }
        if (wr == 0) PG8_BAR;
        E(acc, cur, wr, wc, fr, fq);
        if (!has_next) break;
#pragma unroll
        for (int a = 0; a < 2; ++a)
#pragma unroll
            for (int b = 0; b < 2; ++b)
#pragma unroll
                for (int m = 0; m < 4; ++m)
#pragma unroll
                    for (int n = 0; n < 2; ++n) acc[a][b][m][n] = (f32x4){0.f, 0.f, 0.f, 0.f};
        cur = nxt; cA = nA; cB = nB; ++ui;
        if (wr == 1) PG8_BAR;
    }
    PG8_WAIT_V(0);
    PG8_BAR;
#undef PG8_SA
#undef PG8_SB
#undef PG8_STAGE
#undef PG8_LDA
#undef PG8_LDB
#undef PG8_MMA
#undef PG8_WAIT_V
#undef PG8_WAIT_L
#undef PG8_BAR
#undef PG8_SCHED
}

struct EpiMod {
    static constexpr bool PERM = false;
    float* mod; const float* bias;
    __device__ __forceinline__ void operator()(const f32x4 (&acc)[2][2][4][2], const Unit& u, int wr, int wc, int fr, int fq) const {
        const int col0 = u.pn * BM + wc * 32 + 4 * fq;
        f32x4 bv[2][2];
#pragma unroll
        for (int bj = 0; bj < 2; ++bj)
#pragma unroll
            for (int n = 0; n < 2; ++n) bv[bj][n] = *(const f32x4*)(bias + col0 + bj * HALF + n * 16);
#pragma unroll
        for (int ai = 0; ai < 2; ++ai)
#pragma unroll
            for (int m = 0; m < 4; ++m) { const int row = ai * HALF + wr * 64 + m * 16 + fr; if (row < 129) {
#pragma unroll
                for (int bj = 0; bj < 2; ++bj)
#pragma unroll
                    for (int n = 0; n < 2; ++n) { const int c = col0 + bj * HALF + n * 16; *(f32x4*)(mod + (size_t)row * NMOD + c) = acc[ai][bj][m][n] + bv[bj][n]; } } }
    }
};
struct EpiBf16 {
    static constexpr bool PERM = true;
    bf16_t* O; int ldc;
    __device__ __forceinline__ void operator()(const f32x4 (&acc)[2][2][4][2], const Unit& u, int wr, int wc, int fr, int fq) const {
        const int row0 = u.pm * BM + wr * 64 + fr, col0 = u.pn * BM + wc * 32 + 8 * fq;
#pragma unroll
        for (int ai = 0; ai < 2; ++ai)
#pragma unroll
            for (int m = 0; m < 4; ++m) { bf16_t* rowp = O + (size_t)(row0 + ai * HALF + m * 16) * ldc + col0;
#pragma unroll
                for (int bj = 0; bj < 2; ++bj) { const f32x4 v0 = acc[ai][bj][m][0], v1 = acc[ai][bj][m][1];
                    u32x4 w; w.x = cvt_pk_bf16(v0[0], v0[1]); w.y = cvt_pk_bf16(v0[2], v0[3]); w.z = cvt_pk_bf16(v1[0], v1[1]); w.w = cvt_pk_bf16(v1[2], v1[3]);
                    *(u32x4*)(rowp + bj * HALF) = w; } }
    }
};
struct EpiGU {
    static constexpr bool PERM = true;
    bf16_t* O; int ldc;
    __device__ __forceinline__ void operator()(const f32x4 (&acc)[2][2][4][2], const Unit& u, int wr, int wc, int fr, int fq) const {
        const int row0 = u.pm * BM + wr * 64 + fr, col0 = u.pn * HALF + wc * 32 + 8 * fq;
#pragma unroll
        for (int ai = 0; ai < 2; ++ai)
#pragma unroll
            for (int m = 0; m < 4; ++m) { bf16_t* rowp = O + (size_t)(row0 + ai * HALF + m * 16) * ldc + col0;
                float r[8];
#pragma unroll
                for (int n = 0; n < 2; ++n)
#pragma unroll
                    for (int e = 0; e < 4; ++e) { const float gt = acc[ai][0][m][n][e], up = acc[ai][1][m][n][e]; r[n * 4 + e] = gt * __builtin_amdgcn_rcpf(1.f + __expf(-gt)) * up; }
                *(u32x4*)rowp = pack8(r); }
    }
};
__device__ __forceinline__ void store_partials(const f32x4 (&acc)[2][2][4][2], const Unit& u, int row0, int col0, const float* gate, float* part) {
    int poff = (u.kz * MS + (row0 - SP)) * D + col0; asm volatile("" : "+v"(poff));
#pragma unroll
    for (int am = 0; am < 4; ++am) { f32x4 gv[2][2][2];
#pragma unroll
        for (int m2 = 0; m2 < 2; ++m2) { const int rr = row0 - SP + (am >> 1) * HALF + ((am & 1) * 2 + m2) * 16; const int go = (rr >> 2) * NMOD + col0;
#pragma unroll
            for (int bj = 0; bj < 2; ++bj)
#pragma unroll
                for (int n = 0; n < 2; ++n) gv[m2][bj][n] = *(const f32x4*)(gate + (go + bj * HALF + n * 16)); }
#pragma unroll
        for (int m2 = 0; m2 < 2; ++m2) { const int po = poff + ((am >> 1) * HALF + ((am & 1) * 2 + m2) * 16) * D;
#pragma unroll
            for (int bj = 0; bj < 2; ++bj)
#pragma unroll
                for (int n = 0; n < 2; ++n) *(f32x4*)(part + (po + bj * HALF + n * 16)) = gv[m2][bj][n] * acc[am >> 1][bj][(am & 1) * 2 + m2][n]; } }
}
struct EpiRes {
    static constexpr bool PERM = false;
    float* out; const float* res0; const float* res1; const float* gate; float* part;
    __device__ __forceinline__ void operator()(const f32x4 (&acc)[2][2][4][2], const Unit& u, int wr, int wc, int fr, int fq) const {
        const int row0 = u.pm * BM + wr * 64 + fr, col0 = u.pn * BM + wc * 32 + 4 * fq;
        if (u.pm >= 32) { store_partials(acc, u, row0, col0, gate, part); return; }
        f32x4 gv[2][2];
#pragma unroll
        for (int bj = 0; bj < 2; ++bj)
#pragma unroll
            for (int n = 0; n < 2; ++n) gv[bj][n] = *(const f32x4*)(gate + (size_t)128 * NMOD + col0 + bj * HALF + n * 16);
        int roff = row0 * D + col0; asm volatile("" : "+v"(roff));
#pragma unroll
        for (int am = 0; am < 4; ++am) { f32x4 rv[2][2][2];
#pragma unroll
            for (int m2 = 0; m2 < 2; ++m2)
#pragma unroll
                for (int bj = 0; bj < 2; ++bj)
#pragma unroll
                    for (int n = 0; n < 2; ++n) rv[m2][bj][n] = *(const f32x4*)(res0 + (roff + ((am >> 1) * HALF + ((am & 1) * 2 + m2) * 16) * D + bj * HALF + n * 16));
#pragma unroll
            for (int m2 = 0; m2 < 2; ++m2)
#pragma unroll
                for (int bj = 0; bj < 2; ++bj)
#pragma unroll
                    for (int n = 0; n < 2; ++n) *(f32x4*)(out + (roff + ((am >> 1) * HALF + ((am & 1) * 2 + m2) * 16) * D + bj * HALF + n * 16)) = rv[m2][bj][n] + gv[bj][n] * acc[am >> 1][bj][(am & 1) * 2 + m2][n]; }
    }
};
struct EpiResNorm {
    static constexpr bool PERM = false;
    float* out; const float* res0; const float* gate; float* part; const float* nw; float* ssq; unsigned* pcnt; LAS float* red;
    __device__ __forceinline__ void operator()(const f32x4 (&acc)[2][2][4][2], const Unit& u, int wr, int wc, int fr, int fq) const {
        const int row0 = u.pm * BM + wr * 64 + fr, col0 = u.pn * BM + wc * 32 + 4 * fq, tid = threadIdx.x;
        if (u.pm >= 32) { store_partials(acc, u, row0, col0, gate, part); return; }
        const float* gp = gate + (size_t)128 * NMOD;
        int roff = row0 * D + col0; asm volatile("" : "+v"(roff));
#pragma unroll
        for (int ai = 0; ai < 2; ++ai)
#pragma unroll
            for (int m = 0; m < 4; ++m) { const int ro = roff + (ai * HALF + m * 16) * D; float ps = 0.f;
#pragma unroll
                for (int bj = 0; bj < 2; ++bj)
#pragma unroll
                    for (int n = 0; n < 2; ++n) { const int o = bj * HALF + n * 16; const f32x4 rv = *(const f32x4*)(res0 + (ro + o)), gv = *(const f32x4*)(gp + (col0 + o));
                        const f32x4 v = rv + gv * acc[ai][bj][m][n]; ps += v[0] * v[0] + v[1] * v[1] + v[2] * v[2] + v[3] * v[3]; }
                ps += __shfl_xor(ps, 16); ps += __shfl_xor(ps, 32);
                if (fq == 0) red[(ai * HALF + wr * 64 + m * 16 + fr) * 4 + wc] = ps; }
        __syncthreads();
        if (tid < 256) { const f32x4 r4 = *(const LAS f32x4*)(red + tid * 4);
            __hip_atomic_store(ssq + (size_t)(u.pm * 8 + u.pn) * 256 + tid, r4[0] + r4[1] + r4[2] + r4[3], __ATOMIC_RELAXED, __HIP_MEMORY_SCOPE_AGENT); }
        asm volatile("s_waitcnt vmcnt(0)" ::: "memory");
        __syncthreads();
        if (tid == 0) { __hip_atomic_fetch_add(pcnt + u.pm, 1u, __ATOMIC_RELAXED, __HIP_MEMORY_SCOPE_AGENT); unsigned sp = 0;
            while (__hip_atomic_load(pcnt + u.pm, __ATOMIC_RELAXED, __HIP_MEMORY_SCOPE_AGENT) < 8u && ++sp < (1u << 22)) __builtin_amdgcn_s_sleep(1); }
        __syncthreads();
        if (tid < 256) { float tot = 0.f; const float* sp = ssq + (size_t)(u.pm * 8) * 256 + tid;
#pragma unroll 1
            for (int j = 0; j < 8; ++j) { tot += __hip_atomic_load(sp, __ATOMIC_RELAXED, __HIP_MEMORY_SCOPE_AGENT); sp += 256; }
            red[1024 + tid] = rsqrtf(tot * (1.f / D) + EPS); }
        __syncthreads();
        int woff = row0 * D + col0; asm volatile("" : "+v"(woff));
        f32x4 gw[2][2], ww[2][2];
#pragma unroll
        for (int bj = 0; bj < 2; ++bj)
#pragma unroll
            for (int n = 0; n < 2; ++n) { gw[bj][n] = *(const f32x4*)(gp + (col0 + bj * HALF + n * 16)); ww[bj][n] = *(const f32x4*)(nw + (col0 + bj * HALF + n * 16)); }
#pragma unroll
        for (int am = 0; am < 4; ++am) { f32x4 rv[2][2][2]; float rr[2];
#pragma unroll
            for (int m2 = 0; m2 < 2; ++m2) { rr[m2] = red[1024 + (am >> 1) * HALF + wr * 64 + ((am & 1) * 2 + m2) * 16 + fr];
#pragma unroll
                for (int bj = 0; bj < 2; ++bj)
#pragma unroll
                    for (int n = 0; n < 2; ++n) rv[m2][bj][n] = *(const f32x4*)(res0 + (woff + ((am >> 1) * HALF + ((am & 1) * 2 + m2) * 16) * D + bj * HALF + n * 16)); }
#pragma unroll
            for (int m2 = 0; m2 < 2; ++m2)
#pragma unroll
                for (int bj = 0; bj < 2; ++bj)
#pragma unroll
                    for (int n = 0; n < 2; ++n) *(f32x4*)(out + (woff + ((am >> 1) * HALF + ((am & 1) * 2 + m2) * 16) * D + bj * HALF + n * 16)) = (rv[m2][bj][n] + gw[bj][n] * acc[am >> 1][bj][(am & 1) * 2 + m2][n]) * rr[m2] * ww[bj][n]; }
    }
};
}

struct Frame {
    LAS unsigned char* lds;
    int tid, lane, wave, G, bid;
    const float* in[23];
    float* out; unsigned char* ws;
};

struct TileDesc { const float* src; bf16_t* dst; int ldn, K, k0, n0, kind; };
__device__ __forceinline__ TileDesc tile_desc(const Frame& F, int t) {
    unsigned char* ws = F.ws; TileDesc d; int NT, idx; d.kind = 0;
    if (t < 1536) { d.src = F.in[12]; d.ldn = NMOD; d.K = D; NT = 48; idx = t; d.dst = (bf16_t*)(ws + WS_WADA); }
    else if (t < 2240) { d.src = F.in[14]; d.ldn = INW; d.K = D; NT = 22; idx = t - 1536; d.dst = (bf16_t*)(ws + WS_WIN); }
    else if (t < 2496) { d.src = F.in[19]; d.ldn = D; d.K = D; NT = 8; idx = t - 2240; d.dst = (bf16_t*)(ws + WS_WOUT); }
    else if (t < 3200) { d.src = F.in[20]; d.ldn = DFF; d.K = D; NT = 22; idx = t - 2496; d.dst = (bf16_t*)(ws + WS_WGU); d.kind = 1; }
    else if (t < 3904) { d.src = F.in[21]; d.ldn = DFF; d.K = D; NT = 22; idx = t - 3200; d.dst = (bf16_t*)(ws + WS_WGU); d.kind = 2; }
    else { d.src = F.in[22]; d.ldn = D; d.K = DFF; NT = 8; idx = t - 3904; d.dst = (bf16_t*)(ws + WS_WDN); }
    d.n0 = (idx % NT) * 256; d.k0 = (idx / NT) * 64; return d;
}
__device__ __forceinline__ void convert_tiles(const Frame& F, int tlo, int thi, int wb, int nw) {
    LAS float* tile = (LAS float*)F.lds;
    int t = tlo + wb; if (t >= thi) return;
    TileDesc d = tile_desc(F, t);
    f32x4 v[8];
#pragma unroll
    for (int i = 0; i < 8; ++i) v[i] = __builtin_nontemporal_load((const f32x4*)(d.src + (size_t)(d.k0 + i * 8 + F.wave) * d.ldn + d.n0 + F.lane * 4));
    for (;;) {
#pragma unroll
        for (int i = 0; i < 8; ++i) { LAS float* tp = tile + (i * 8 + F.wave) * 257 + F.lane * 4; tp[0] = v[i][0]; tp[1] = v[i][1]; tp[2] = v[i][2]; tp[3] = v[i][3]; }
        __syncthreads();
        const int tn = t + nw; const bool more = tn < thi; TileDesc dn = d;
        if (more) { dn = tile_desc(F, tn);
#pragma unroll
            for (int i = 0; i < 8; ++i) v[i] = __builtin_nontemporal_load((const f32x4*)(dn.src + (size_t)(dn.k0 + i * 8 + F.wave) * dn.ldn + dn.n0 + F.lane * 4)); }
#pragma unroll
        for (int it = 0; it < 4; ++it) { const int item = it * 512 + F.tid, n = item >> 3, kg = item & 7;
            float f[8];
#pragma unroll
            for (int j = 0; j < 8; ++j) f[j] = tile[(kg * 8 + j) * 257 + n];
            const int nn = d.n0 + n; const int row = d.kind == 0 ? nn : (((nn >> 7) << 8) + (nn & 127) + (d.kind == 2 ? 128 : 0));
            *(u32x4*)(d.dst + (size_t)row * d.K + d.k0 + kg * 8) = pack8(f); }
        __syncthreads();
        if (!more) break;
        t = tn; d = dn;
    }
}

__device__ __forceinline__ void p0_prologue(const Frame& F) {
    unsigned char* ws = F.ws;
    convert_tiles(F, 0, 2496, F.bid, F.G);
    const int gt = F.bid * 512 + F.tid, GT = F.G * 512;
    { bf16_t* sc = (bf16_t*)(ws + WS_SILU);
      for (int i = gt; i < 256 * D / 2; i += GT) { const int r = (i * 2) >> 11, c = (i * 2) & 2047; float a = 0.f, b = 0.f;
          if (r < 128) { a = F.in[8][r * D + c]; b = F.in[8][r * D + c + 1]; } else if (r == 128) { a = F.in[7][c]; b = F.in[7][c + 1]; }
          a = a / (1.f + expf(-a)); b = b / (1.f + expf(-b));
          *(unsigned*)(sc + (size_t)i * 2) = cvt_pk_bf16(a, b); } }
    { float* rt = (float*)(ws + WS_ROPE);
      for (int i = gt; i < 8196 * 8; i += GT) { const int pi = i >> 3, f = i & 7; const int pos = pi < SP ? pi : 16384 + (pi - SP);
          const float inv = f == 0 ? 1.0f : f == 1 ? 0.1939227432012558f : f == 2 ? 0.03760603070259094f : f == 3 ? 0.007292664609849453f : f == 4 ? 0.0014142135623842478f : f == 5 ? 0.00027424818836152554f : f == 6 ? 5.318296098266728e-05f : 1.0313386155758053e-05f;
          const float ang = (float)pos * inv; const double a = (double)ang; const double k = rint(a * 0.15915494309189535); const float r = (float)(a - k * 6.283185307179586);
          rt[pi * 16 + f] = cosf(r); rt[pi * 16 + 8 + f] = sinf(r); } }
    { float* wg = (float*)(ws + WS_WG); for (int i = gt; i < 8 * D; i += GT) { const int j = i >> 11, c = i & 2047; wg[i] = F.in[14][(size_t)c * INW + NIN + j]; } }
}

__device__ __forceinline__ void kvwin_copy(const Frame& F, int gt, int GT) {
    const int per = 124 * 64;
    for (int i0 = gt; i0 < NB * per; i0 += 4 * GT) { f32x4 a[4], b[4]; size_t so[4], dof[4];
#pragma unroll
        for (int u = 0; u < 4; ++u) { const int i = i0 + u * GT; const int ii = i < NB * per ? i : 0; const int bb = ii / per, o = ii - bb * per; so[u] = (size_t)bb * 8192 + 256 + o; dof[u] = (size_t)bb * 8192 + o;
            a[u] = __builtin_nontemporal_load((const f32x4*)F.in[2] + so[u]); b[u] = __builtin_nontemporal_load((const f32x4*)F.in[3] + so[u]); }
#pragma unroll
        for (int u = 0; u < 4; ++u) { if (i0 + u * GT < NB * per) { __builtin_nontemporal_store(a[u], (f32x4*)(F.out + O_KWS) + dof[u]); __builtin_nontemporal_store(b[u], (f32x4*)(F.out + O_VWS) + dof[u]); } } }
}

template <bool GATES>
__device__ __forceinline__ void norm_mod_phase(const Frame& F, const float* src0, const float* src1, const float* nw, int sh_off, int sc_off, int nparts, float* x1out) {
    const float* mod = (const float*)(F.ws + WS_MOD);
    bf16_t* H = (bf16_t*)(F.ws + WS_H);
    LAS float* wg = (LAS float*)F.lds;
    if (GATES) { const f32x4* s = (const f32x4*)(F.ws + WS_WG); for (int i = F.tid; i < 8 * D / 4; i += 512) ((LAS f32x4*)wg)[i] = s[i]; __syncthreads(); }
    f32x4 av[8], shv[8];
    { const float* mr = mod + (size_t)128 * NMOD;
#pragma unroll
      for (int i = 0; i < 8; ++i) { const int c4 = i * 64 + F.lane; const f32x4 w = ((const f32x4*)nw)[c4], sc = ((const f32x4*)(mr + sc_off))[c4]; shv[i] = ((const f32x4*)(mr + sh_off))[c4]; av[i] = w * (sc + 1.f); } }
    for (int r = F.bid * 8 + F.wave; r < MTOT; r += F.G * 8) {
        const float* xr = r < SP ? src0 + (size_t)r * D : src1 + (size_t)(r - SP) * D;
        f32x4 xv[8]; float ss = 0.f;
#pragma unroll
        for (int i = 0; i < 8; ++i) xv[i] = ((const f32x4*)xr)[i * 64 + F.lane];
        if (r >= SP) { const float* mr = mod + (size_t)((r - SP) >> 2) * NMOD;
#pragma unroll
            for (int i = 0; i < 8; ++i) { const int c4 = i * 64 + F.lane; const f32x4 w = ((const f32x4*)nw)[c4], sc = ((const f32x4*)(mr + sc_off))[c4]; shv[i] = ((const f32x4*)(mr + sh_off))[c4]; av[i] = w * (sc + 1.f); }
            if (nparts > 0) {
                for (int z = 0; z < nparts; ++z) { const f32x4* pp = (const f32x4*)(F.ws + WS_PART) + ((size_t)z * MS + (r - SP)) * (D / 4);
#pragma unroll
                    for (int i = 0; i < 8; ++i) xv[i] += pp[i * 64 + F.lane]; }
#pragma unroll
                for (int i = 0; i < 8; ++i) ((f32x4*)(x1out + (size_t)(r - SP) * D))[i * 64 + F.lane] = xv[i]; } }
#pragma unroll
        for (int i = 0; i < 8; ++i) ss += xv[i][0] * xv[i][0] + xv[i][1] * xv[i][1] + xv[i][2] * xv[i][2] + xv[i][3] * xv[i][3];
        ss = wave_sum(ss);
        const float rstd = rsqrtf(ss * (1.f / D) + EPS);
        float g[8];
#pragma unroll
        for (int j = 0; j < 8; ++j) g[j] = 0.f;
#pragma unroll
        for (int i = 0; i < 8; ++i) { const int c4 = i * 64 + F.lane;
            f32x4 h;
#pragma unroll
            for (int e = 0; e < 4; ++e) h[e] = (xv[i][e] * rstd) * av[i][e] + shv[i][e];
            u32x2 pk; pk.x = cvt_pk_bf16(h[0], h[1]); pk.y = cvt_pk_bf16(h[2], h[3]);
            *(u32x2*)(H + (size_t)r * D + c4 * 4) = pk;
            if (GATES) {
#pragma unroll
                for (int j = 0; j < 8; ++j) { const f32x4 wv = ((const LAS f32x4*)(wg + j * D))[c4]; g[j] += h[0] * wv[0] + h[1] * wv[1] + h[2] * wv[2] + h[3] * wv[3]; } } }
        if (GATES) {
#pragma unroll
            for (int j = 0; j < 8; ++j) g[j] = wave_sum(g[j]);
            if (F.lane == 0) { float* gp = (float*)(F.ws + WS_GATES) + (size_t)r * 8;
                *(f32x4*)gp = (f32x4){g[0], g[1], g[2], g[3]}; *(f32x4*)(gp + 4) = (f32x4){g[4], g[5], g[6], g[7]}; } }
    }
    if (GATES) __syncthreads();
}

__device__ __forceinline__ void mlstm_scan(const Frame& F, int hh) {
    LAS float* sB = (LAS float*)F.lds;
    LAS float* sW = sB + SP;
    LAS float* sM = sW + SP;
    LAS float* tot = sM + SP;
    const float* gates = (const float*)(F.ws + WS_GATES);
    const float big = F.in[15][hh], bfg = F.in[16][hh];
    float cB = 0.f, cM = -INFINITY;
    for (int it = 0; it < 16; ++it) { const int t = F.wave * 1024 + it * 64 + F.lane;
        const float li = gates[(size_t)t * 8 + hh] + big; float v = logsigmoid_(gates[(size_t)t * 8 + 4 + hh] + bfg);
#pragma unroll
        for (int d = 1; d < 64; d <<= 1) { const float o = __shfl_up(v, d); if (F.lane >= d) v += o; }
        const float Bl = cB + v; const float wl = li - Bl; float mx = wl;
#pragma unroll
        for (int d = 1; d < 64; d <<= 1) { const float o = __shfl_up(mx, d); if (F.lane >= d) mx = fmaxf(mx, o); }
        mx = fmaxf(mx, cM);
        sB[t] = Bl; sW[t] = wl; sM[t] = mx;
        cB = __shfl(Bl, 63); cM = __shfl(mx, 63); }
    if (F.lane == 0) { tot[F.wave] = cB; tot[8 + F.wave] = cM; }
    __syncthreads();
    float Boff = 0.f, Min = 0.f;
    for (int w = 0; w < F.wave; ++w) { Min = fmaxf(Min, tot[8 + w] - Boff); Boff += tot[w]; }
    float* BC = (float*)(F.ws + WS_BC) + hh * SP; float* BW = (float*)(F.ws + WS_BW) + hh * SP; float* MR = (float*)(F.ws + WS_MR) + hh * SP;
    for (int it = 0; it < 16; ++it) { const int t = F.wave * 1024 + it * 64 + F.lane;
        const float B = Boff + sB[t], W = sW[t] - Boff, M = fmaxf(Min, sM[t] - Boff);
        BC[t] = B; BW[t] = W; MR[t] = M;
        if (t == SP - 1) F.out[O_MP + hh] = B + M; }
    __syncthreads();
}

__device__ __forceinline__ void attn_prompt_unit(const Frame& F, int qb, int g) {
    const bf16_t* P = (const bf16_t*)(F.ws + WS_P); const float* rope = (const float*)(F.ws + WS_ROPE);
    bf16_t* MIX = (bf16_t*)(F.ws + WS_MIX);
    LAS bf16_t* Ks = (LAS bf16_t*)F.lds;
    LAS bf16_t* Vt = Ks + 192 * 72;
    LAS bf16_t* Pw = Vt + 64 * 200 + F.wave * (16 * 200);
    const int q0 = qb * 64, lane = F.lane, fr = lane & 15, kg = lane >> 4, dgs = F.tid & 7;
    const int hq = g * 4 + (F.wave & 3), qh = F.wave >> 2;
    u32x4 qn0, qn1, qno; f32x4 qnc[4];
#define ATT_QLOAD(qtx) do { const int trx = q0 + qh * 32 + (qtx) * 16 + fr; const bf16_t* rowx = P + (size_t)trx * NIN + C_AQ + hq * 64; qn0 = *(const u32x4*)(rowx + kg * 8); qn1 = *(const u32x4*)(rowx + 32 + kg * 8); \
        if (kg < 2) { qno = *(const u32x4*)(rowx + (kg ^ 1) * 8); _Pragma("unroll") for (int k = 0; k < 4; ++k) qnc[k] = *(const f32x4*)(rope + (size_t)trx * 16 + 4 * k); } } while (0)
    ATT_QLOAD(0);
    u32x4 kv[3], ov[3], vv[2][2]; f32x4 kc[3][4];
#pragma unroll
    for (int it = 0; it < 3; ++it) { const int key = (it * 512 + F.tid) >> 3, kp = q0 - 128 + key; kv[it] = *(const u32x4*)(P + (size_t)(kp < 0 ? 0 : kp) * NIN + C_AK + g * 64 + dgs * 8); }
    if (dgs < 2) {
#pragma unroll
        for (int it = 0; it < 3; ++it) { const int key = (it * 512 + F.tid) >> 3, kp = q0 - 128 + key, kpc = kp < 0 ? 0 : kp; ov[it] = *(const u32x4*)(P + (size_t)kpc * NIN + C_AK + g * 64 + (dgs ^ 1) * 8);
#pragma unroll
            for (int k = 0; k < 4; ++k) kc[it][k] = *(const f32x4*)(rope + (size_t)kpc * 16 + 4 * k); } }
#pragma unroll
    for (int it = 0; it < 2; ++it) { const int item = it * 512 + F.tid; const int k2 = item < 768 ? item % 96 : 0, dg = item < 768 ? item / 96 : 0, kp = q0 - 128 + 2 * k2;
        const bf16_t* row = P + (size_t)(kp < 0 ? 0 : kp) * NIN + C_AV + g * 64 + dg * 8; vv[it][0] = *(const u32x4*)row; vv[it][1] = *(const u32x4*)(row + NIN); }
#pragma unroll
    for (int it = 0; it < 3; ++it) { const int key = (it * 512 + F.tid) >> 3, kp = q0 - 128 + key; u32x4 k4 = kv[it];
        if (dgs < 2) { float a[8], b[8]; unpack8(k4, a); unpack8(ov[it], b);
#pragma unroll
            for (int i = 0; i < 8; ++i) { const float cs = kc[it][i >> 2][i & 3], sn = kc[it][2 + (i >> 2)][i & 3]; a[i] = (dgs == 0) ? a[i] * cs - b[i] * sn : a[i] * cs + b[i] * sn; }
            k4 = pack8(a); }
        if (kp < 0) k4 = (u32x4){0u, 0u, 0u, 0u};
        *(LAS u32x4*)(Ks + key * 72 + dgs * 8) = k4; }
#pragma unroll
    for (int it = 0; it < 2; ++it) { const int item = it * 512 + F.tid; if (item < 768) { const int k2 = item % 96, dg = item / 96, kp = q0 - 128 + 2 * k2;
        u32x4 v0 = vv[it][0], v1 = vv[it][1]; if (kp < 0) { v0 = (u32x4){0u, 0u, 0u, 0u}; v1 = v0; }
        unsigned w[8]; zip8(v0, v1, w);
#pragma unroll
        for (int i = 0; i < 8; ++i) *(LAS unsigned*)(Vt + (dg * 8 + i) * 200 + 2 * k2) = w[i]; } }
    __syncthreads();
    const float sink = F.in[17][hq];
    for (int qt = 0; qt < 2; ++qt) {
        const int tq = q0 + qh * 32 + qt * 16;
        bf16x8 qf[2];
        { u32x4 qv = qn0;
          if (kg < 2) { float a[8], b[8]; unpack8(qv, a); unpack8(qno, b);
#pragma unroll
              for (int i = 0; i < 8; ++i) { const float cs = qnc[i >> 2][i & 3], sn = qnc[2 + (i >> 2)][i & 3]; a[i] = (kg == 0) ? a[i] * cs - b[i] * sn : a[i] * cs + b[i] * sn; }
              qv = pack8(a); }
          qf[0] = __builtin_bit_cast(bf16x8, qv); qf[1] = __builtin_bit_cast(bf16x8, qn1); }
        if (qt == 0) ATT_QLOAD(1);
        f32x4 s[12];
#pragma unroll
        for (int kt = 0; kt < 12; ++kt) { s[kt] = (f32x4){0.f, 0.f, 0.f, 0.f};
#pragma unroll
            for (int ks = 0; ks < 2; ++ks) { const bf16x8 kf = *(const LAS bf16x8*)(Ks + (kt * 16 + fr) * 72 + ks * 32 + kg * 8);
                s[kt] = __builtin_amdgcn_mfma_f32_16x16x32_bf16(kf, qf[ks], s[kt], 0, 0, 0); } }
        const int qp = tq + fr; float m = sink;
#pragma unroll
        for (int kt = 0; kt < 12; ++kt)
#pragma unroll
            for (int j = 0; j < 4; ++j) { const int kp = q0 - 128 + kt * 16 + kg * 4 + j; const bool ok = (kp >= 0) && (kp <= qp) && (qp - kp < 128);
                const float v = ok ? s[kt][j] * 0.125f : -INFINITY; s[kt][j] = v; m = fmaxf(m, v); }
        m = fmaxf(m, __shfl_xor(m, 16)); m = fmaxf(m, __shfl_xor(m, 32));
        float sum = 0.f;
        asm volatile("" ::: "memory");
#pragma unroll
        for (int kt = 0; kt < 12; ++kt) {
#pragma unroll
            for (int j = 0; j < 4; ++j) { const float p = __expf(s[kt][j] - m); s[kt][j] = p; sum += p; }
            u32x2 pk; pk.x = cvt_pk_bf16(s[kt][0], s[kt][1]); pk.y = cvt_pk_bf16(s[kt][2], s[kt][3]);
            *(LAS u32x2*)(Pw + fr * 200 + kt * 16 + kg * 4) = pk; }
        asm volatile("" ::: "memory");
        sum += __shfl_xor(sum, 16); sum += __shfl_xor(sum, 32);
        const float linv = 1.f / (sum + __expf(sink - m));
        f32x4 o[4];
#pragma unroll
        for (int dt = 0; dt < 4; ++dt) o[dt] = (f32x4){0.f, 0.f, 0.f, 0.f};
#pragma unroll
        for (int kk = 0; kk < 6; ++kk) { const bf16x8 pf = *(const LAS bf16x8*)(Pw + fr * 200 + kk * 32 + kg * 8);
#pragma unroll
            for (int dt = 0; dt < 4; ++dt) { const bf16x8 vf = *(const LAS bf16x8*)(Vt + (dt * 16 + fr) * 200 + kk * 32 + kg * 8);
                o[dt] = __builtin_amdgcn_mfma_f32_16x16x32_bf16(pf, vf, o[dt], 0, 0, 0); } }
#pragma unroll
        for (int j = 0; j < 4; ++j) { const float inv = __shfl(linv, kg * 4 + j); bf16_t* op = MIX + (size_t)(tq + kg * 4 + j) * D + hq * 64 + fr;
#pragma unroll
            for (int dt = 0; dt < 4; ++dt) op[dt * 16] = (bf16_t)(cvt_pk_bf16(o[dt][j] * inv, 0.f) & 0xffff); }
    }
    __syncthreads();
}

#undef ATT_QLOAD
__device__ __forceinline__ void attn_sample_wave(const Frame& F, int unit) {
    const bf16_t* P = (const bf16_t*)(F.ws + WS_P); const float* rope = (const float*)(F.ws + WS_ROPE);
    bf16_t* MIX = (bf16_t*)(F.ws + WS_MIX);
    const int b = unit >> 4, hq = unit & 15, g = hq >> 2, lane = F.lane;
    LAS float* base = (LAS float*)F.lds + F.wave * 1408;
    LAS float* sq = base; LAS float* sk = base + 256; LAS float* sv = base + 512; LAS float* sp = base + 768;
    float q4[4], k4[4], v4[4], qo4[4], ko4[4], c4[4], s4[4];
#pragma unroll
    for (int t = 0; t < 4; ++t) { const bf16_t* row = P + (size_t)(SP + b * 4 + t) * NIN; const float* cs = rope + (size_t)(SP + t) * 16;
        q4[t] = bf2f(row[C_AQ + hq * 64 + lane]); k4[t] = bf2f(row[C_AK + g * 64 + lane]); v4[t] = bf2f(row[C_AV + g * 64 + lane]);
        qo4[t] = bf2f(row[C_AQ + hq * 64 + ((lane ^ 8) & 15)]); ko4[t] = bf2f(row[C_AK + g * 64 + ((lane ^ 8) & 15)]); c4[t] = cs[lane & 7]; s4[t] = cs[8 + (lane & 7)]; }
#pragma unroll
    for (int t = 0; t < 4; ++t) { float qv = q4[t], kv = k4[t]; const float vv = v4[t];
        if (lane < 16) { const float c = c4[t], sn = s4[t]; if (lane < 8) { qv = qv * c - qo4[t] * sn; kv = kv * c - ko4[t] * sn; } else { qv = qv * c + qo4[t] * sn; kv = kv * c + ko4[t] * sn; } }
        sq[t * 64 + lane] = qv * 0.125f; sk[t * 64 + lane] = kv; sv[t * 64 + lane] = vv;
        if ((hq & 3) == 0) { F.out[O_KWS + ((size_t)b * 128 + 124 + t) * 256 + g * 64 + lane] = kv; F.out[O_VWS + ((size_t)b * 128 + 124 + t) * 256 + g * 64 + lane] = vv; } }
    const float sink = F.in[17][hq];
    float sc[3][4];
#pragma unroll
    for (int kk = 0; kk < 3; ++kk) { const int kidx = kk * 64 + lane;
#pragma unroll
        for (int t = 0; t < 4; ++t) sc[kk][t] = 0.f;
        if (kidx < 128) { const f32x4* kr = (const f32x4*)(F.in[2] + ((size_t)b * 128 + kidx) * 256 + g * 64);
#pragma unroll 8
            for (int d4 = 0; d4 < 16; ++d4) { const f32x4 kv = kr[d4];
#pragma unroll
                for (int t = 0; t < 4; ++t) { const f32x4 q = *(const LAS f32x4*)(sq + t * 64 + d4 * 4); sc[kk][t] += kv[0] * q[0] + kv[1] * q[1] + kv[2] * q[2] + kv[3] * q[3]; } } }
        else if (kidx < 132) { const int tn = kidx - 128;
#pragma unroll 4
            for (int d = 0; d < 64; ++d) { const float kv = sk[tn * 64 + d];
#pragma unroll
                for (int t = 0; t < 4; ++t) sc[kk][t] += kv * sq[t * 64 + d]; } }
#pragma unroll
        for (int t = 0; t < 4; ++t) { const bool ok = (kidx < 132) && (kidx > t) && (kidx <= t + 128); if (!ok) sc[kk][t] = -INFINITY; } }
    float linv[4];
#pragma unroll
    for (int t = 0; t < 4; ++t) { float m = fmaxf(fmaxf(sc[0][t], sc[1][t]), sc[2][t]); m = fmaxf(wave_max(m), sink);
        float sum = 0.f;
#pragma unroll
        for (int kk = 0; kk < 3; ++kk) { const float p = __expf(sc[kk][t] - m); sum += p; const int kidx = kk * 64 + lane; if (kidx < 160) sp[t * 160 + kidx] = p; }
        sum = wave_sum(sum) + __expf(sink - m); linv[t] = 1.f / sum; }
    const int kq = lane >> 4, dq = lane & 15;
    f32x4 o[4];
#pragma unroll
    for (int t = 0; t < 4; ++t) o[t] = (f32x4){0.f, 0.f, 0.f, 0.f};
    const float* vb = F.in[3] + ((size_t)b * 128 + kq) * 256 + g * 64 + dq * 4;
#pragma unroll 8
    for (int kb = 0; kb < 32; ++kb) { const f32x4 vv = *(const f32x4*)(vb + (size_t)kb * 1024);
#pragma unroll
        for (int t = 0; t < 4; ++t) o[t] += vv * sp[t * 160 + kb * 4 + kq]; }
    { const f32x4 vv = *(const LAS f32x4*)(sv + kq * 64 + dq * 4);
#pragma unroll
      for (int t = 0; t < 4; ++t) o[t] += vv * sp[t * 160 + 128 + kq]; }
#pragma unroll
    for (int t = 0; t < 4; ++t) {
#pragma unroll
        for (int e = 0; e < 4; ++e) { float v = o[t][e]; v += __shfl_xor(v, 16); v += __shfl_xor(v, 32); o[t][e] = v * linv[t]; }
        if (kq == t) { u32x2 pk; pk.x = cvt_pk_bf16(o[t][0], o[t][1]); pk.y = cvt_pk_bf16(o[t][2], o[t][3]); *(u32x2*)(MIX + (size_t)(SP + b * 4 + t) * D + hq * 64 + dq * 4) = pk; } }
}

__device__ __forceinline__ void mlstm_sample_unit(const Frame& F, int b, int h) {
    const bf16_t* P = (const bf16_t*)(F.ws + WS_P); const float* gates = (const float*)(F.ws + WS_GATES);
    bf16_t* MIX = (bf16_t*)(F.ws + WS_MIX);
    LAS float* sq = (LAS float*)F.lds; LAS float* sk = sq + 1024; LAS float* sv = sk + 1024; LAS float* sS = sv + 1024;
    const int tid = F.tid, lane = F.lane;
    const int bh = b * 4 + h;
    for (int i = tid; i < 1024; i += 512) { const int t = i >> 8, d = i & 255; const bf16_t* row = P + (size_t)(SP + b * 4 + t) * NIN;
        sq[i] = bf2f(row[C_MQ + h * 256 + d]) * 0.0625f; sk[i] = bf2f(row[C_MK + h * 256 + d]); sv[i] = bf2f(row[C_MV + h * 256 + d]); }
    if (tid < 64) sS[tid] = 0.f;
    __syncthreads();
    {
        const int pair = tid >> 5, sub = tid & 31, t = pair >> 2, s = pair & 3; float a = 0.f, c = 0.f;
#pragma unroll
        for (int e = 0; e < 8; ++e) { const int d = sub * 8 + e; a += sq[t * 256 + d] * sk[s * 256 + d]; if (s == 0) c += sq[t * 256 + d] * F.in[5][(size_t)bh * 256 + d]; }
#pragma unroll
        for (int o = 16; o >= 1; o >>= 1) { a += __shfl_xor(a, o); c += __shfl_xor(c, o); }
        if (sub == 0) { sS[pair] = a; if (s == 0) sS[16 + t] = c; } }
    __syncthreads();
    float li[4], bcum[4], mt[4], at[4], gs[4], sm[4][4], den[4];
    const float m0 = F.in[6][bh];
    { float acc = 0.f;
#pragma unroll
      for (int t = 0; t < 4; ++t) { const float* gp = gates + (size_t)(SP + b * 4 + t) * 8; li[t] = gp[h] + F.in[15][h]; acc += logsigmoid_fast(gp[4 + h] + F.in[16][h]); bcum[t] = acc; } }
#pragma unroll
    for (int t = 0; t < 4; ++t) { const float mi = bcum[t] + m0; float m = mi;
#pragma unroll
        for (int s = 0; s < 4; ++s) if (s <= t) m = fmaxf(m, bcum[t] - bcum[s] + li[s]);
        mt[t] = m; at[t] = __expf(mi - m); float dsum = at[t] * sS[16 + t];
#pragma unroll
        for (int s = 0; s < 4; ++s) { sm[t][s] = (s <= t) ? sS[t * 4 + s] * __expf(bcum[t] - bcum[s] + li[s] - m) : 0.f; dsum += sm[t][s]; }
        den[t] = fmaxf(fabsf(dsum), __expf(-m)); }
    const float mnew = mt[3], decay = __expf(bcum[3] + m0 - mnew);
#pragma unroll
    for (int s = 0; s < 4; ++s) gs[s] = __expf(bcum[3] - bcum[s] + li[s] - mnew);
    const int r8 = lane >> 3, seg = lane & 7, w = F.wave;
    const float* c0b = F.in[4] + (size_t)bh * 65536 + (size_t)(w * 32 + r8) * 256 + seg * 4;
    float* c1b = F.out + O_CS + (size_t)bh * 65536 + (size_t)(w * 32 + r8) * 256 + seg * 4;
    float acc[4][4], gv[4][4];
#pragma unroll
    for (int rg = 0; rg < 4; ++rg)
#pragma unroll
        for (int t = 0; t < 4; ++t) { acc[rg][t] = 0.f; gv[rg][t] = gs[t] * sv[t * 256 + w * 32 + rg * 8 + r8]; }
    if (tid == 0) {
#pragma unroll
        for (int t = 0; t < 4; ++t) { sS[40 + t] = at[t]; sS[44 + t] = den[t];
#pragma unroll
            for (int s2 = 0; s2 < 4; ++s2) sS[48 + t * 4 + s2] = sm[t][s2]; } }
    f32x4 c[2][2][4];
#pragma unroll
    for (int i2 = 0; i2 < 2; ++i2)
#pragma unroll
        for (int rg = 0; rg < 4; ++rg) c[0][i2][rg] = __builtin_nontemporal_load((const f32x4*)(c0b + rg * 2048 + i2 * 32));
#pragma unroll
    for (int hh = 0; hh < 4; ++hh) {
        if (hh < 3) {
#pragma unroll
            for (int i2 = 0; i2 < 2; ++i2)
#pragma unroll
                for (int rg = 0; rg < 4; ++rg) c[(hh + 1) & 1][i2][rg] = __builtin_nontemporal_load((const f32x4*)(c0b + rg * 2048 + ((hh + 1) * 2 + i2) * 32)); }
#pragma unroll
        for (int i2 = 0; i2 < 2; ++i2) { const int it = hh * 2 + i2; const int d = it * 32 + seg * 4;
            f32x4 q[4], k[4];
#pragma unroll
            for (int t = 0; t < 4; ++t) { q[t] = *(const LAS f32x4*)(sq + t * 256 + d); k[t] = *(const LAS f32x4*)(sk + t * 256 + d); }
#pragma unroll
            for (int rg = 0; rg < 4; ++rg) { const f32x4 cv = c[hh & 1][i2][rg]; f32x4 nv = cv * decay;
#pragma unroll
                for (int t = 0; t < 4; ++t) { acc[rg][t] += cv[0] * q[t][0] + cv[1] * q[t][1] + cv[2] * q[t][2] + cv[3] * q[t][3]; nv += k[t] * gv[rg][t]; }
                __builtin_nontemporal_store(nv, (f32x4*)(c1b + rg * 2048 + it * 32)); } }
    }
    __syncthreads();
    float hv[4][4], ssq[4] = {0.f, 0.f, 0.f, 0.f};
#pragma unroll
    for (int rg = 0; rg < 4; ++rg)
#pragma unroll
        for (int t = 0; t < 4; ++t) { float a = acc[rg][t]; a += __shfl_xor(a, 1); a += __shfl_xor(a, 2); a += __shfl_xor(a, 4);
            float num = sS[40 + t] * a;
#pragma unroll
            for (int s2 = 0; s2 < 4; ++s2) num += sS[48 + t * 4 + s2] * sv[s2 * 256 + w * 32 + rg * 8 + r8];
            hv[rg][t] = num / sS[44 + t]; if (seg == 0) ssq[t] += hv[rg][t] * hv[rg][t]; }
#pragma unroll
    for (int t = 0; t < 4; ++t) { ssq[t] = wave_sum(ssq[t]); }
    if (lane == 0) {
#pragma unroll
        for (int t = 0; t < 4; ++t) lds_add(&sS[32 + t], ssq[t]); }
    if (tid < 256) { float nn = decay * F.in[5][(size_t)bh * 256 + tid];
#pragma unroll
        for (int s2 = 0; s2 < 4; ++s2) nn += gs[s2] * sk[s2 * 256 + tid];
        F.out[O_NS + (size_t)bh * 256 + tid] = nn; }
    if (tid == 0) F.out[O_MS + bh] = mnew;
    __syncthreads();
#pragma unroll
    for (int rg = 0; rg < 4; ++rg)
#pragma unroll
        for (int t = 0; t < 4; ++t) if (seg == ((rg * 4 + t) & 7)) { const int vr = w * 32 + rg * 8 + r8; const size_t row = (size_t)(SP + b * 4 + t);
            const float rms = rsqrtf(sS[32 + t] * (1.f / 256.f) + EPS); const float og = sigmoidf_(bf2f(P[row * NIN + C_MO + h * 256 + vr]));
            MIX[row * D + 1024 + h * 256 + vr] = (bf16_t)(cvt_pk_bf16(hv[rg][t] * rms * F.in[18][h * 256 + vr] * og, 0.f) & 0xffff); }
    __syncthreads();
}

__device__ __forceinline__ void mlstm_u_unit(const Frame& F, int c, int h, int vh) {
    const bf16_t* P = (const bf16_t*)(F.ws + WS_P);
    const float* BW = (const float*)(F.ws + WS_BW) + h * SP; const float* MR = (const float*)(F.ws + WS_MR) + h * SP;
    LAS bf16_t* VtS = (LAS bf16_t*)F.lds;
    LAS bf16_t* KtS = VtS + 128 * 72;
    LAS float* gS = (LAS float*)(KtS + 256 * 72);
    const int lane = F.lane, fr = lane & 15, kg = lane >> 4, w = F.wave;
    const float mend = MR[c * LC + LC - 1];
    f32x4 acc[4][4];
#pragma unroll
    for (int a = 0; a < 4; ++a)
#pragma unroll
        for (int b = 0; b < 4; ++b) acc[a][b] = (f32x4){0.f, 0.f, 0.f, 0.f};
    float un = 0.f;
    u32x4 vr0, vr1, kr[2][2]; float bw0, bw1, bwg;
#define D1_LOAD(sbx) do { const int s0x = c * LC + (sbx) * 64; { const int s2 = F.tid & 31, vg = F.tid >> 5; bw0 = BW[s0x + 2 * s2]; bw1 = BW[s0x + 2 * s2 + 1]; bwg = BW[s0x + (F.tid & 63)]; \
            const bf16_t* src = P + (size_t)(s0x + 2 * s2) * NIN + C_MV + h * 256 + vh * 128 + vg * 8; vr0 = *(const u32x4*)src; vr1 = *(const u32x4*)(src + NIN); } \
        _Pragma("unroll") for (int it = 0; it < 2; ++it) { const int item = it * 512 + F.tid, s2 = item & 31, dg = item >> 5; const bf16_t* src = P + (size_t)(s0x + 2 * s2) * NIN + C_MK + h * 256 + dg * 8; \
            kr[it][0] = *(const u32x4*)src; kr[it][1] = *(const u32x4*)(src + NIN); } } while (0)
    D1_LOAD(0);
    for (int sb = 0; sb < LC / 64; ++sb) {
        if (F.tid < 64) gS[F.tid] = __expf(bwg - mend);
        { const int s2 = F.tid & 31, vg = F.tid >> 5; const float g0 = __expf(bw0 - mend), g1 = __expf(bw1 - mend);
            float f0[8], f1[8]; unpack8(vr0, f0); unpack8(vr1, f1);
#pragma unroll
            for (int i = 0; i < 8; ++i) *(LAS unsigned*)(VtS + (vg * 8 + i) * 72 + 2 * s2) = cvt_pk_bf16(f0[i] * g0, f1[i] * g1); }
#pragma unroll
        for (int it = 0; it < 2; ++it) { const int item = it * 512 + F.tid, s2 = item & 31, dg = item >> 5;
            unsigned wd[8]; zip8(kr[it][0], kr[it][1], wd);
#pragma unroll
            for (int i = 0; i < 8; ++i) *(LAS unsigned*)(KtS + (dg * 8 + i) * 72 + 2 * s2) = wd[i]; }
        if (sb + 1 < LC / 64) D1_LOAD(sb + 1);
        __syncthreads();
#pragma unroll
        for (int ks = 0; ks < 2; ++ks) { bf16x8 vf[4];
#pragma unroll
            for (int vt = 0; vt < 4; ++vt) vf[vt] = *(const LAS bf16x8*)(VtS + ((w & 1) * 64 + vt * 16 + fr) * 72 + ks * 32 + kg * 8);
#pragma unroll
            for (int dt = 0; dt < 4; ++dt) { const bf16x8 kf = *(const LAS bf16x8*)(KtS + ((w >> 1) * 64 + dt * 16 + fr) * 72 + ks * 32 + kg * 8);
#pragma unroll
                for (int vt = 0; vt < 4; ++vt) acc[dt][vt] = __builtin_amdgcn_mfma_f32_16x16x32_bf16(kf, vf[vt], acc[dt][vt], 0, 0, 0); } }
        if (vh == 0 && F.tid < 256) {
#pragma unroll
            for (int j8 = 0; j8 < 8; ++j8) { float kf[8]; unpack8(*(const LAS u32x4*)(KtS + F.tid * 72 + j8 * 8), kf); const f32x4 ga = *(const LAS f32x4*)(gS + j8 * 8), gb = *(const LAS f32x4*)(gS + j8 * 8 + 4);
                un += ga[0] * kf[0] + ga[1] * kf[1] + ga[2] * kf[2] + ga[3] * kf[3] + gb[0] * kf[4] + gb[1] * kf[5] + gb[2] * kf[6] + gb[3] * kf[7]; } }
        __syncthreads(); }
    float* U = (float*)(F.ws + WS_U) + ((size_t)(c * 4 + h) * 256) * 256;
#pragma unroll
    for (int dt = 0; dt < 4; ++dt)
#pragma unroll
        for (int vt = 0; vt < 4; ++vt) { const int v = vh * 128 + (w & 1) * 64 + vt * 16 + fr, d = (w >> 1) * 64 + dt * 16 + kg * 4; *(f32x4*)(U + (size_t)v * 256 + d) = acc[dt][vt]; }
    if (vh == 0 && F.tid < 256) ((float*)(F.ws + WS_UN))[(c * 4 + h) * 256 + F.tid] = un;
}

#undef D1_LOAD
__device__ __forceinline__ void mlstm_state_scan(const Frame& F) {
    const float* MRb = (const float*)(F.ws + WS_MR);
    const float* U = (const float*)(F.ws + WS_U); bf16_t* CST = (bf16_t*)(F.ws + WS_CST);
    LAS float* sdec = (LAS float*)F.lds;
    if (F.tid < 128) { const int h = F.tid >> 5, c = F.tid & 31; const float* MR = MRb + h * SP; sdec[F.tid] = expf((c == 0 ? 0.f : MR[c * LC - 1]) - MR[c * LC + LC - 1]); }
    __syncthreads();
    const int gt = F.bid * 512 + F.tid, GT = F.G * 512;
    typedef float f32x2 __attribute__((ext_vector_type(2)));
    for (int e2 = gt; e2 < 131072; e2 += GT) { const int h = e2 >> 15;
        f32x2 C = (f32x2){0.f, 0.f};
#pragma unroll 1
        for (int c0 = 0; c0 < NCH; c0 += 8) { f32x2 u[8];
#pragma unroll
            for (int k = 0; k < 8; ++k) u[k] = *(const f32x2*)(U + (size_t)(c0 + k) * 262144 + (size_t)e2 * 2);
#pragma unroll
            for (int k = 0; k < 8; ++k) { *(unsigned*)(CST + (size_t)(c0 + k) * 262144 + (size_t)e2 * 2) = cvt_pk_bf16(C[0], C[1]); C = C * sdec[h * 32 + c0 + k] + u[k]; } }
        *(f32x2*)(F.out + O_CP + (size_t)e2 * 2) = C; }
    for (int e = gt; e < 1024; e += GT) { const int h = e >> 8; const float* UN = (const float*)(F.ws + WS_UN); float* NST = (float*)(F.ws + WS_NST);
        float n = 0.f;
        for (int c = 0; c < NCH; ++c) { NST[c * 1024 + e] = n; n = n * sdec[h * 32 + c] + UN[c * 1024 + e]; }
        F.out[O_NP + e] = n; }
    __syncthreads();
}

__device__ __forceinline__ void mlstm_out_unit(const Frame& F, int c, int h, int tb) {
    const bf16_t* P = (const bf16_t*)(F.ws + WS_P); bf16_t* MIX = (bf16_t*)(F.ws + WS_MIX);
    const float* BC = (const float*)(F.ws + WS_BC) + h * SP; const float* BW = (const float*)(F.ws + WS_BW) + h * SP; const float* MR = (const float*)(F.ws + WS_MR) + h * SP;
    const bf16_t* CST = (const bf16_t*)(F.ws + WS_CST) + (size_t)(c * 4 + h) * 65536; const float* NST = (const float*)(F.ws + WS_NST) + (c * 4 + h) * 256;
    LAS bf16_t* Qs = (LAS bf16_t*)F.lds;
    LAS bf16_t* Ks = Qs + 64 * 264;
    LAS bf16_t* VtS = Ks + 64 * 264;
    LAS bf16_t* Ps = VtS + 256 * 72;
    LAS float* sA = (LAS float*)(Ps + 64 * 72);
    LAS float* sDen = sA + 64;
    LAS float* sMr = sDen + 64;
    LAS float* sSq = sMr + 64;
    const int tid = F.tid, lane = F.lane, fr = lane & 15, kg = lane >> 4, w = F.wave;
    const int t0 = c * LC + tb * 64;
    const float mstart = c == 0 ? 0.f : MR[c * LC - 1];
#pragma unroll
    for (int it = 0; it < 4; ++it) { const int item = it * 512 + tid, t = item >> 5, dg = item & 31;
        *(LAS u32x4*)(Qs + t * 264 + dg * 8) = *(const u32x4*)(P + (size_t)(t0 + t) * NIN + C_MQ + h * 256 + dg * 8); }
    u32x4 kreg[4], vreg[2][2];
#define P6_LOAD(sbx) do { const int s0x = c * LC + (sbx) * 64; _Pragma("unroll") for (int it = 0; it < 4; ++it) { const int item = it * 512 + tid, sx = item >> 5, dg = item & 31; \
            kreg[it] = *(const u32x4*)(P + (size_t)(s0x + sx) * NIN + C_MK + h * 256 + dg * 8); } \
        _Pragma("unroll") for (int it = 0; it < 2; ++it) { const int item = it * 512 + tid, s2 = item & 31, vg = item >> 5; const bf16_t* src = P + (size_t)(s0x + 2 * s2) * NIN + C_MV + h * 256 + vg * 8; \
            vreg[it][0] = *(const u32x4*)src; vreg[it][1] = *(const u32x4*)(src + NIN); } } while (0)
    P6_LOAD(0);
    if (tid < 64) { const float mr = MR[t0 + tid]; sMr[tid] = mr; sA[tid] = expf(mstart - mr) * 0.0625f; sSq[tid] = 0.f; }
    __syncthreads();
    {
        const int t = tid >> 3, sub = tid & 7; float a = 0.f; f32x4 nv[8];
#pragma unroll
        for (int e4 = 0; e4 < 8; ++e4) nv[e4] = *(const f32x4*)(NST + sub * 32 + e4 * 4);
#pragma unroll
        for (int e4 = 0; e4 < 8; ++e4) { const u32x2 qq = *(const LAS u32x2*)(Qs + t * 264 + sub * 32 + e4 * 4);
            a += bf_lo(qq.x) * nv[e4][0] + bf_hi(qq.x) * nv[e4][1] + bf_lo(qq.y) * nv[e4][2] + bf_hi(qq.y) * nv[e4][3]; }
        a += __shfl_xor(a, 1); a += __shfl_xor(a, 2); a += __shfl_xor(a, 4);
        if (sub == 0) sDen[t] = a * sA[t]; }
    f32x4 acc[4][2];
#pragma unroll
    for (int a = 0; a < 4; ++a) { acc[a][0] = (f32x4){0.f, 0.f, 0.f, 0.f}; acc[a][1] = acc[a][0]; }
    { bf16x8 cf[8][2];
#pragma unroll
      for (int ks = 0; ks < 8; ++ks)
#pragma unroll
          for (int vt = 0; vt < 2; ++vt) cf[ks][vt] = __builtin_bit_cast(bf16x8, *(const u32x4*)(CST + (size_t)(w * 32 + vt * 16 + fr) * 256 + ks * 32 + kg * 8));
#pragma unroll
      for (int ks = 0; ks < 8; ++ks)
#pragma unroll
          for (int tt = 0; tt < 4; ++tt) { const bf16x8 qf = *(const LAS bf16x8*)(Qs + (tt * 16 + fr) * 264 + ks * 32 + kg * 8);
#pragma unroll
              for (int vt = 0; vt < 2; ++vt) acc[tt][vt] = __builtin_amdgcn_mfma_f32_16x16x32_bf16(qf, cf[ks][vt], acc[tt][vt], 0, 0, 0); } }
#pragma unroll
    for (int tt = 0; tt < 4; ++tt)
#pragma unroll
        for (int j = 0; j < 4; ++j) { const float a = sA[tt * 16 + kg * 4 + j]; acc[tt][0][j] *= a; acc[tt][1][j] *= a; }
    __syncthreads();
    for (int sb = 0; sb <= tb; ++sb) { const int s0 = c * LC + sb * 64;
#pragma unroll
        for (int it = 0; it < 4; ++it) { const int item = it * 512 + tid, sx = item >> 5, dg = item & 31; *(LAS u32x4*)(Ks + sx * 264 + dg * 8) = kreg[it]; }
#pragma unroll
        for (int it = 0; it < 2; ++it) { const int item = it * 512 + tid, s2 = item & 31, vg = item >> 5;
            unsigned wd[8]; zip8(vreg[it][0], vreg[it][1], wd);
#pragma unroll
            for (int i = 0; i < 8; ++i) *(LAS unsigned*)(VtS + (vg * 8 + i) * 72 + 2 * s2) = wd[i]; }
        if (sb < tb) P6_LOAD(sb + 1);
        __syncthreads();
        {
            const int tt = w >> 1; f32x4 sacc[2]; sacc[0] = (f32x4){0.f, 0.f, 0.f, 0.f}; sacc[1] = sacc[0];
#pragma unroll 2
            for (int ks = 0; ks < 8; ++ks) { const bf16x8 qf = *(const LAS bf16x8*)(Qs + (tt * 16 + fr) * 264 + ks * 32 + kg * 8);
#pragma unroll
                for (int x = 0; x < 2; ++x) { const bf16x8 kf = *(const LAS bf16x8*)(Ks + (((w & 1) * 2 + x) * 16 + fr) * 264 + ks * 32 + kg * 8);
                    sacc[x] = __builtin_amdgcn_mfma_f32_16x16x32_bf16(qf, kf, sacc[x], 0, 0, 0); } }
            float rs[4] = {0.f, 0.f, 0.f, 0.f};
#pragma unroll
            for (int x = 0; x < 2; ++x) { const int sl = ((w & 1) * 2 + x) * 16 + fr; const float ws = BW[s0 + sl];
#pragma unroll
                for (int j = 0; j < 4; ++j) { const int tl = tt * 16 + kg * 4 + j; const bool ok = (s0 + sl) <= (t0 + tl);
                    const float pv = ok ? sacc[x][j] * 0.0625f * expf(ws - sMr[tl]) : 0.f; rs[j] += pv;
                    Ps[tl * 72 + sl] = (bf16_t)(cvt_pk_bf16(pv, 0.f) & 0xffff); } }
#pragma unroll
            for (int j = 0; j < 4; ++j) { float r = rs[j]; r += __shfl_xor(r, 1); r += __shfl_xor(r, 2); r += __shfl_xor(r, 4); r += __shfl_xor(r, 8);
                if (fr == 0) lds_add(&sDen[tt * 16 + kg * 4 + j], r); } }
        __syncthreads();
#pragma unroll
        for (int ks = 0; ks < 2; ++ks) { bf16x8 vf[2];
#pragma unroll
            for (int vt = 0; vt < 2; ++vt) vf[vt] = *(const LAS bf16x8*)(VtS + (w * 32 + vt * 16 + fr) * 72 + ks * 32 + kg * 8);
#pragma unroll
            for (int tt = 0; tt < 4; ++tt) { const bf16x8 pf = *(const LAS bf16x8*)(Ps + (tt * 16 + fr) * 72 + ks * 32 + kg * 8);
#pragma unroll
                for (int vt = 0; vt < 2; ++vt) acc[tt][vt] = __builtin_amdgcn_mfma_f32_16x16x32_bf16(pf, vf[vt], acc[tt][vt], 0, 0, 0); } }
        __syncthreads(); }
#pragma unroll
    for (int tt = 0; tt < 4; ++tt)
#pragma unroll
        for (int j = 0; j < 4; ++j) { const int tl = tt * 16 + kg * 4 + j; const float mt = BC[t0 + tl] + sMr[tl]; const float dn = 1.f / fmaxf(fabsf(sDen[tl]), expf(-mt));
            acc[tt][0][j] *= dn; acc[tt][1][j] *= dn; float q = acc[tt][0][j] * acc[tt][0][j] + acc[tt][1][j] * acc[tt][1][j];
            q += __shfl_xor(q, 1); q += __shfl_xor(q, 2); q += __shfl_xor(q, 4); q += __shfl_xor(q, 8);
            if (fr == 0) lds_add(&sSq[tl], q); }
    __syncthreads();
    {
        float ogp[4][4][2]; const float nw0 = F.in[18][h * 256 + w * 32 + fr], nw1 = F.in[18][h * 256 + w * 32 + 16 + fr];
#pragma unroll
        for (int tt = 0; tt < 4; ++tt)
#pragma unroll
            for (int j = 0; j < 4; ++j) { const size_t row = (size_t)(t0 + tt * 16 + kg * 4 + j);
#pragma unroll
                for (int vt = 0; vt < 2; ++vt) ogp[tt][j][vt] = bf2f(P[row * NIN + C_MO + h * 256 + w * 32 + vt * 16 + fr]); }
#pragma unroll
        for (int tt = 0; tt < 4; ++tt)
#pragma unroll
            for (int j = 0; j < 4; ++j) { const int tl = tt * 16 + kg * 4 + j; const float rms = rsqrtf(sSq[tl] * (1.f / 256.f) + EPS); const size_t row = (size_t)(t0 + tl);
#pragma unroll
                for (int vt = 0; vt < 2; ++vt) { const int v = w * 32 + vt * 16 + fr;
                    MIX[row * D + 1024 + h * 256 + v] = (bf16_t)(cvt_pk_bf16(acc[tt][vt][j] * rms * (vt == 0 ? nw0 : nw1) * sigmoidf_(ogp[tt][j][vt]), 0.f) & 0xffff); } } }
    __syncthreads();
}

#undef P6_LOAD
__device__ __forceinline__ void final_norm_phase(const Frame& F, int rlo) {
    const float* nw = F.in[11];
    for (int r = rlo + F.bid * 8 + F.wave; r < MTOT; r += F.G * 8) { f32x4* xr = (f32x4*)(F.out + (size_t)r * D);
        const f32x4* sr = r < SP ? xr : (const f32x4*)(F.ws + WS_X1) + (size_t)r * (D / 4);
        f32x4 xv[8]; float ss = 0.f;
#pragma unroll
        for (int i = 0; i < 8; ++i) xv[i] = sr[i * 64 + F.lane];
        if (r >= SP) { for (int z = 0; z < 11; ++z) { const f32x4* pp = (const f32x4*)(F.ws + WS_PART) + ((size_t)z * MS + (r - SP)) * (D / 4);
#pragma unroll
                for (int i = 0; i < 8; ++i) xv[i] += pp[i * 64 + F.lane]; } }
#pragma unroll
        for (int i = 0; i < 8; ++i) ss += xv[i][0] * xv[i][0] + xv[i][1] * xv[i][1] + xv[i][2] * xv[i][2] + xv[i][3] * xv[i][3];
        ss = wave_sum(ss); const float rstd = rsqrtf(ss * (1.f / D) + EPS);
#pragma unroll
        for (int i = 0; i < 8; ++i) { const f32x4 w = ((const f32x4*)nw)[i * 64 + F.lane]; xr[i * 64 + F.lane] = xv[i] * rstd * w; } }
}

__global__ void __launch_bounds__(512, 2) fwd_mega(Params prm) {
    extern __shared__ __attribute__((aligned(16))) unsigned char lds_raw[];
    cg::grid_group grid = cg::this_grid();
    Frame F;
    F.lds = (LAS unsigned char*)lds_raw; F.tid = threadIdx.x; F.lane = F.tid & 63; F.wave = __builtin_amdgcn_readfirstlane(F.tid >> 6); F.G = gridDim.x; F.bid = blockIdx.x;
#pragma unroll
    for (int i = 0; i < 23; ++i) F.in[i] = prm.in[i];
    F.out = prm.out; F.ws = prm.ws;
    unsigned char* ws = F.ws;
    const int lo = prm.ph_lo, hi = prm.ph_hi;
#ifndef PH_MASK
#define PH_MASK 0xfff
#endif
#define IN(k) (((PH_MASK >> (k)) & 1) && lo <= (k) && (k) < hi)
#define SEAM(k) do { if (IN(k) && IN((k) + 1)) { if ((k) == 0) grid.sync(); else xcd_barrier(xbar); } } while (0)
#ifndef REPMASK
#define REPMASK 0
#endif
#define REPS(k) for (int rep_ = 0; rep_ < 1 + ((REPMASK >> (k)) & 1); ++rep_, (((REPMASK >> (k)) & 1) && rep_ == 1 ? grid.sync() : (void)0))
    const float* mod = (const float*)(ws + WS_MOD);
    volatile LAS unsigned* xst = (volatile LAS unsigned*)(F.lds + LDS_BYTES - 16);
    if (F.tid == 0) { xst[0] = 0u; xst[1] = 0u; }
    __syncthreads();
    XcdBarrier xbar; xbar.bar = (unsigned*)(ws + WS_BAR); xbar.x = 0; xbar.st = xst;
    if (hi - lo > 1) xbar = xcd_barrier_post((unsigned*)(ws + WS_BAR), xst);

    if (IN(0)) REPS(0) p0_prologue(F);
    SEAM(0);
    if (IN(1)) { { const int cb = F.G > 96 ? 48 : 0;
          if (F.bid >= cb) convert_tiles(F, 2496, 4608, F.bid - cb, F.G - cb); }
        pg8::Gemm g{(const bf16_t*)(ws + WS_SILU), (const bf16_t*)(ws + WS_WADA), D, D}; pg8::SplitKOrder S{48, 1, F.G, F.bid, 32};
        pg8::EpiMod E{(float*)(ws + WS_MOD), F.in[13]}; pg8::gemm_phase(F.lds, g, S, E); }
    SEAM(1);
    if (IN(2)) REPS(2) norm_mod_phase<true>(F, F.in[0], F.in[1], F.in[9], 0, 2048, 0, nullptr);
    SEAM(2);
    if (IN(3)) REPS(3) {
        if (F.bid >= F.G - 4) mlstm_scan(F, F.bid - (F.G - 4));
        pg8::Gemm g{(const bf16_t*)(ws + WS_H), (const bf16_t*)(ws + WS_WIN), D, D}; pg8::StaticOrder S; S.init(MTOT, NIN, F.G, F.bid, D / 64);
        pg8::EpiBf16 E{(bf16_t*)(ws + WS_P), NIN}; pg8::gemm_phase(F.lds, g, S, E); }
    SEAM(3);
    if (IN(4)) REPS(4) {
        const bool cfirst = (F.bid & 1) != 0;
        if (cfirst && (prm.p4m & 2)) for (int u = F.bid; u < 256; u += F.G) mlstm_sample_unit(F, u >> 2, u & 3);
        if (prm.p4m & 1) for (int u = F.bid; u < 256; u += F.G) mlstm_u_unit(F, u >> 3, (u >> 1) & 3, u & 1);
        if (prm.p4m & 4) for (int u = F.bid; u < 512; u += F.G) attn_prompt_unit(F, u >> 2, u & 3);
        if (prm.p4m & 8) for (int rep = 0; rep < ((prm.p4m & 16) ? 2 : 1); ++rep) for (int u = F.bid * 8 + F.wave; u < 2048; u += F.G * 8) attn_sample_wave(F, u);
        if (!cfirst && (prm.p4m & 2)) for (int u = F.bid; u < 256; u += F.G) mlstm_sample_unit(F, u >> 2, u & 3);
        { const bf16_t* P = (const bf16_t*)(ws + WS_P); const float* rope = (const float*)(ws + WS_ROPE);
          for (int i = F.bid * 512 + F.tid; i < 32768; i += F.G * 512) { const int pos = SP - 128 + (i >> 8), cc = i & 255, d = cc & 63; const bf16_t* row = P + (size_t)pos * NIN;
              float kv = bf2f(row[C_AK + cc]);
              if (d < 16) { const float ko = bf2f(row[C_AK + (cc ^ 8)]); const float cs = rope[pos * 16 + (d & 7)], sn = rope[pos * 16 + 8 + (d & 7)]; kv = d < 8 ? kv * cs - ko * sn : kv * cs + ko * sn; }
              F.out[O_KWP + i] = kv; F.out[O_VWP + i] = bf2f(row[C_AV + cc]); } }
    }
    SEAM(4);
    if (IN(5)) REPS(5) mlstm_state_scan(F);
    SEAM(5);
    if (IN(6)) REPS(6) { const bool cfirst6 = (F.bid & 1) != 0;
        if (cfirst6) for (int u = 256 + F.bid; u < 512; u += F.G) mlstm_sample_unit(F, u >> 2, u & 3);
        for (int u = F.bid; u < 512; u += F.G) { const int tb = u < 256 ? 3 - (u >> 7) : ((u - 256) >> 7); const int ch = u & 127; mlstm_out_unit(F, ch >> 2, ch & 3, tb); }
        if (!cfirst6) for (int u = 256 + F.bid; u < 512; u += F.G) mlstm_sample_unit(F, u >> 2, u & 3); }
    SEAM(6);
    if (IN(7)) REPS(7) { pg8::Gemm g{(const bf16_t*)(ws + WS_MIX), (const bf16_t*)(ws + WS_WOUT), D, D}; pg8::PromptSampleOrder S{F.G, F.bid, D / 64, 4};
        pg8::EpiRes E{(float*)(ws + WS_X1), F.in[0], F.in[1], mod + 4096, (float*)(ws + WS_PART)}; pg8::gemm_phase(F.lds, g, S, E);
        if (F.G == 256) { if (F.bid >= 64) kvwin_copy(F, (F.bid - 64) * 512 + F.tid, (F.G - 64) * 512); } else kvwin_copy(F, F.bid * 512 + F.tid, F.G * 512); }
    SEAM(7);
    if (IN(8)) REPS(8) { float* x1 = (float*)(ws + WS_X1); norm_mod_phase<false>(F, x1, F.in[1], F.in[10], 3 * 2048, 4 * 2048, 4, x1 + (size_t)SP * D); }
    SEAM(8);
    if (IN(9)) REPS(9) { pg8::Gemm g{(const bf16_t*)(ws + WS_H), (const bf16_t*)(ws + WS_WGU), D, D}; pg8::StaticOrder S; S.init(MTOT, 2 * DFF, F.G, F.bid, D / 64);
        pg8::EpiGU E{(bf16_t*)(ws + WS_P), DFF}; pg8::gemm_phase(F.lds, g, S, E); }
    SEAM(9);
    if (IN(10)) REPS(10) { const float* x1 = (const float*)(ws + WS_X1); pg8::Gemm g{(const bf16_t*)(ws + WS_P), (const bf16_t*)(ws + WS_WDN), DFF, DFF}; pg8::PromptSampleOrder S{F.G, F.bid, DFF / 64, 11};
        if (F.G == 256) { pg8::EpiResNorm E{F.out + O_Y, x1, mod + 5 * 2048, (float*)(ws + WS_PART), F.in[11], (float*)(ws + WS_SSQ), (unsigned*)(ws + WS_PCNT), (LAS float*)(F.lds + 131072)}; pg8::gemm_phase(F.lds, g, S, E); }
        else { pg8::EpiRes E{F.out + O_Y, x1, x1 + (size_t)SP * D, mod + 5 * 2048, (float*)(ws + WS_PART)}; pg8::gemm_phase(F.lds, g, S, E); } }
    SEAM(10);
    if (IN(11)) final_norm_phase(F, F.G == 256 ? SP : 0);
#undef IN
#undef SEAM
}

#ifndef MK_MULTI
#define MK_MULTI 0
#endif

extern "C" void kernel_launch(void* const* d_in, const int* in_sizes, int n_in, void* d_out, int out_size, void* d_ws, size_t ws_size, hipStream_t stream) {
    static int grid = 0;
    if (grid == 0) {
        if (n_in != 23 || (size_t)out_size != O_END || ws_size < WS_END) { fprintf(stderr, "kernel_launch: unexpected sizes: n_in %d out %d (want %zu) ws %zu (want >= %zu)\n", n_in, out_size, (size_t)O_END, ws_size, (size_t)WS_END); grid = -1; return; }
        int dev = 0, cus = 0, per_cu = 0;
        (void)hipGetDevice(&dev); (void)hipDeviceGetAttribute(&cus, hipDeviceAttributeMultiprocessorCount, dev);
        if (hipFuncSetAttribute((const void*)fwd_mega, hipFuncAttributeMaxDynamicSharedMemorySize, LDS_BYTES) != hipSuccess) { fprintf(stderr, "kernel_launch: hipFuncSetAttribute failed\n"); grid = -1; return; }
        if (hipOccupancyMaxActiveBlocksPerMultiprocessor(&per_cu, (const void*)fwd_mega, 512, LDS_BYTES) != hipSuccess || per_cu < 1) { fprintf(stderr, "kernel_launch: occupancy query says %d blocks/CU\n", per_cu); per_cu = 1; }
        (void)hipGetLastError();
        grid = cus * 1;
        fprintf(stderr, "kernel_launch: cus %d per_cu %d grid %d ws %zu need %zu\n", cus, per_cu, grid, ws_size, (size_t)WS_END);
    }
    if (grid < 0) return;
    Params p{};
    for (int i = 0; i < 23; ++i) p.in[i] = (const float*)d_in[i];
    p.out = (float*)d_out; p.ws = (unsigned char*)d_ws; p.p4m = 15;
#if MK_MULTI
#ifndef DUPMASK
#define DUPMASK 0
#endif
#ifndef DUP_P4M
#define DUP_P4M 15
#endif
    for (int ph = 0; ph < NPHASE; ++ph) for (int r = 0; r < 1 + ((DUPMASK >> ph) & 1); ++r) { p.ph_lo = ph; p.ph_hi = ph + 1; p.p4m = (r == 1 && ph == 4) ? DUP_P4M : 15; hipLaunchKernelGGL(fwd_mega, dim3(grid), dim3(512), LDS_BYTES, stream, p); }
#else
    p.ph_lo = 0; p.ph_hi = NPHASE;
    (void)hipMemsetAsync((unsigned char*)d_ws + WS_BAR, 0, 16384, stream);
    void* args[] = {&p};
    hipError_t e = hipLaunchCooperativeKernel((const void*)fwd_mega, dim3(grid), dim3(512), args, LDS_BYTES, stream);
    if (e != hipSuccess) fprintf(stderr, "cooperative launch failed: %s (grid %d)\n", hipGetErrorString(e), grid);
#endif
}
```

```cpp
#include <hip/hip_runtime.h>
#include <hip/hip_cooperative_groups.h>
#include <cstdio>
#include <cstdint>
namespace cg = cooperative_groups;

#define LAS __attribute__((address_space(3)))
typedef unsigned short bf16_t;
typedef short bf16x8 __attribute__((ext_vector_type(8)));
typedef float f32x4 __attribute__((ext_vector_type(4)));
typedef unsigned u32x4 __attribute__((ext_vector_type(4)));
typedef unsigned u32x2 __attribute__((ext_vector_type(2)));

constexpr int D = 2048, SP = 8192, NB = 128, TS = 4, MS = NB * TS, MTOT = SP + MS;
constexpr int NIN = 5632, INW = 5640, DFF = 5632, NMOD = 12288;
constexpr int C_AQ = 0, C_AK = 1024, C_AV = 1280, C_MQ = 1536, C_MK = 2560, C_MV = 3584, C_MO = 4608;
constexpr float EPS = 1e-6f;
constexpr int LC = 256, NCH = SP / LC;

constexpr size_t al256(size_t x) { return (x + 255) & ~(size_t)255; }
constexpr size_t WS_WADA = 0;
constexpr size_t WS_WIN = WS_WADA + (size_t)NMOD * D * 2;
constexpr size_t WS_WOUT = WS_WIN + (size_t)NIN * D * 2;
constexpr size_t WS_WGU = WS_WOUT + (size_t)D * D * 2;
constexpr size_t WS_WDN = WS_WGU + (size_t)2 * DFF * D * 2;
constexpr size_t WS_SILU = WS_WDN + (size_t)D * DFF * 2;
constexpr size_t WS_MOD = WS_SILU + (size_t)256 * D * 2;
constexpr size_t WS_H = al256(WS_MOD + (size_t)129 * NMOD * 4);
constexpr size_t WS_GATES = WS_H + (size_t)MTOT * D * 2;
constexpr size_t WS_P = al256(WS_GATES + (size_t)MTOT * 8 * 4);
constexpr size_t WS_MIX = WS_P + (size_t)MTOT * NIN * 2;
constexpr size_t WS_X1 = WS_MIX + (size_t)MTOT * D * 2;
constexpr size_t WS_ROPE = WS_X1 + (size_t)MTOT * D * 4;
constexpr size_t WS_WG = al256(WS_ROPE + (size_t)8196 * 16 * 4);
constexpr size_t WS_BC = WS_WG + (size_t)8 * D * 4;
constexpr size_t WS_BW = WS_BC + (size_t)4 * SP * 4;
constexpr size_t WS_MR = WS_BW + (size_t)4 * SP * 4;
constexpr size_t WS_U = WS_MR + (size_t)4 * SP * 4;
constexpr size_t WS_UN = WS_U + (size_t)NCH * 4 * 65536 * 4;
constexpr size_t WS_CST = WS_UN + (size_t)NCH * 4 * 256 * 4;
constexpr size_t WS_NST = WS_CST + (size_t)NCH * 4 * 65536 * 2;
constexpr size_t WS_PART = WS_NST + (size_t)NCH * 4 * 256 * 4;
constexpr size_t WS_BAR = WS_PART + (size_t)11 * MS * D * 4;
constexpr size_t WS_SSQ = WS_BAR + 16384;
constexpr size_t WS_END = WS_SSQ + (size_t)256 * 256 * 4;
constexpr size_t WS_PCNT = WS_BAR + 14336;

constexpr size_t O_Y = 0;
constexpr size_t O_KWP = (size_t)MTOT * D;
constexpr size_t O_VWP = O_KWP + 32768;
constexpr size_t O_CP = O_VWP + 32768;
constexpr size_t O_NP = O_CP + 262144;
constexpr size_t O_MP = O_NP + 1024;
constexpr size_t O_KWS = O_MP + 4;
constexpr size_t O_VWS = O_KWS + (size_t)NB * 128 * 256;
constexpr size_t O_CS = O_VWS + (size_t)NB * 128 * 256;
constexpr size_t O_NS = O_CS + (size_t)NB * 4 * 65536;
constexpr size_t O_MS = O_NS + (size_t)NB * 4 * 256;
constexpr size_t O_END = O_MS + (size_t)NB * 4;

constexpr int LDS_BYTES = 147456;
constexpr int NPHASE = 12;

struct Params { const float* in[23]; float* out; unsigned char* ws; int ph_lo, ph_hi, p4m, pad; };

__device__ __forceinline__ unsigned cvt_pk_bf16(float lo, float hi) { unsigned r; asm volatile("v_cvt_pk_bf16_f32 %0, %1, %2" : "=v"(r) : "v"(lo), "v"(hi)); return r; }
__device__ __forceinline__ float bf_lo(unsigned u) { return __uint_as_float(u << 16); }
__device__ __forceinline__ float bf_hi(unsigned u) { return __uint_as_float(u & 0xffff0000u); }
__device__ __forceinline__ float bf2f(bf16_t h) { return __uint_as_float((unsigned)h << 16); }
__device__ __forceinline__ float wave_sum(float v) {
#pragma unroll
    for (int o = 32; o >= 1; o >>= 1) v += __shfl_xor(v, o);
    return v;
}
__device__ __forceinline__ float wave_max(float v) {
#pragma unroll
    for (int o = 32; o >= 1; o >>= 1) v = fmaxf(v, __shfl_xor(v, o));
    return v;
}
__device__ __forceinline__ void lds_add(LAS float* p, float v) { __hip_atomic_fetch_add(p, v, __ATOMIC_RELAXED, __HIP_MEMORY_SCOPE_WORKGROUP); }
__device__ __forceinline__ float sigmoidf_(float x) { return 1.f / (1.f + __expf(-x)); }
__device__ __forceinline__ float logsigmoid_(float x) { return fminf(x, 0.f) - log1pf(expf(-fabsf(x))); }
__device__ __forceinline__ float logsigmoid_fast(float x) { return fminf(x, 0.f) - __logf(1.f + __expf(-fabsf(x))); }
__device__ __forceinline__ void unpack8(const u32x4 v, float (&f)[8]) {
    f[0] = bf_lo(v.x); f[1] = bf_hi(v.x); f[2] = bf_lo(v.y); f[3] = bf_hi(v.y); f[4] = bf_lo(v.z); f[5] = bf_hi(v.z); f[6] = bf_lo(v.w); f[7] = bf_hi(v.w);
}
__device__ __forceinline__ u32x4 pack8(const float (&f)[8]) {
    u32x4 r; r.x = cvt_pk_bf16(f[0], f[1]); r.y = cvt_pk_bf16(f[2], f[3]); r.z = cvt_pk_bf16(f[4], f[5]); r.w = cvt_pk_bf16(f[6], f[7]); return r;
}
__device__ __forceinline__ void zip8(const u32x4 a, const u32x4 b, unsigned (&w)[8]) {
    w[0] = (a.x & 0xffffu) | (b.x << 16); w[1] = (a.x >> 16) | (b.x & 0xffff0000u); w[2] = (a.y & 0xffffu) | (b.y << 16); w[3] = (a.y >> 16) | (b.y & 0xffff0000u);
    w[4] = (a.z & 0xffffu) | (b.z << 16); w[5] = (a.z >> 16) | (b.z & 0xffff0000u); w[6] = (a.w & 0xffffu) | (b.w << 16); w[7] = (a.w >> 16) | (b.w & 0xffff0000u);
}
__device__ __forceinline__ void rope8(float (&own)[8], const float (&oth)[8], const float* cs, int dg) {
#pragma unroll
    for (int i = 0; i < 8; ++i) { const float c = cs[i], s = cs[8 + i]; own[i] = (dg == 0) ? own[i] * c - oth[i] * s : own[i] * c + oth[i] * s; }
}

#define XB_TMO      128
#define XB_XCNT(j)  (256  + 64 * (j))
#define XB_XSUB(j)  (1280 + 64 * (j))
#define XB_XGEN(j)  (2304 + 64 * (j))
#define XB_TOP      3328
#define XB_TOPGEN   3392
#define XCD_BAR_WORDS 3456
#define XB_SPIN_CAP (1u << 18)

__device__ __forceinline__ unsigned xb_ld(unsigned* p)              { return __hip_atomic_load(p, __ATOMIC_RELAXED, __HIP_MEMORY_SCOPE_AGENT); }
__device__ __forceinline__ unsigned xb_add(unsigned* p, unsigned v) { return __hip_atomic_fetch_add(p, v, __ATOMIC_RELAXED, __HIP_MEMORY_SCOPE_AGENT); }
__device__ __forceinline__ unsigned xb_xcc_id() { return (unsigned)__builtin_amdgcn_s_getreg((3 << 11) | 20) & 0xFu; }
#define XB_SPIN(cond, bar) do { unsigned _sp = 0; while (cond) { __builtin_amdgcn_s_sleep(1); \
    if ((++_sp & 255u) == 0u) { if (xb_ld(&(bar)[XB_TMO])) break; if (_sp > XB_SPIN_CAP) { (void)xb_add(&(bar)[XB_TMO], 1u); break; } } } } while (0)

struct XcdBarrier {
    unsigned* bar; unsigned x;
    volatile LAS unsigned* st;
};

__device__ __forceinline__ XcdBarrier xcd_barrier_post(unsigned* bar, volatile LAS unsigned* st) {
    XcdBarrier b; b.bar = bar; b.x = xb_xcc_id(); b.st = st;
    if (threadIdx.x == 0) (void)xb_add(&bar[XB_XCNT(b.x)], 1u);
    return b;
}
__device__ __forceinline__ void xcd_barrier_complete(unsigned* bar, unsigned x, unsigned& nloc, unsigned& nx) {
    const unsigned G = gridDim.x * gridDim.y * gridDim.z;
    unsigned sum, cnt, mine, sp = 0u;
    for (;;) {
        sum = 0u; cnt = 0u; mine = 0u;
#pragma unroll
        for (unsigned j = 0; j < 16; ++j) { const unsigned c = xb_ld(&bar[XB_XCNT(j)]); sum += c; cnt += (c > 0u) ? 1u : 0u; mine = (j == x) ? c : mine; }
        if (sum == G) break;
        __builtin_amdgcn_s_sleep(1);
        if ((++sp & 255u) == 0u) { if (xb_ld(&bar[XB_TMO])) break; if (sp > XB_SPIN_CAP) { (void)xb_add(&bar[XB_TMO], 1u); break; } }
    }
    nloc = mine > 0u ? mine : 1u; nx = cnt > 0u ? cnt : 1u;
}

__device__ __forceinline__ void xcd_barrier(const XcdBarrier& b) {
    asm volatile("s_waitcnt vmcnt(0)" ::: "memory");
    __syncthreads();
    if (threadIdx.x == 0) {
        unsigned* bar = b.bar;
        __builtin_amdgcn_s_waitcnt(0);
        unsigned nloc = b.st[0], nx = b.st[1];
        if (nloc == 0u) { xcd_barrier_complete(bar, b.x, nloc, nx); b.st[0] = nloc; b.st[1] = nx; }
        const unsigned old = xb_add(&bar[XB_XSUB(b.x)], 1u);
        const unsigned gen = old / nloc;
        if (old + 1u == (gen + 1u) * nloc) {
            __builtin_amdgcn_fence(__ATOMIC_RELEASE, "agent");
            asm volatile("s_waitcnt vmcnt(0)" ::: "memory");
            const unsigned og = xb_add(&bar[XB_TOP], 1u);
            const unsigned tg = og / nx;
            if (og + 1u == (tg + 1u) * nx) xb_add(&bar[XB_TOPGEN], 1u);
            else XB_SPIN(xb_ld(&bar[XB_TOPGEN]) == tg, bar);
            __builtin_amdgcn_fence(__ATOMIC_ACQUIRE, "agent");
            xb_add(&bar[XB_XGEN(b.x)], 1u);
            asm volatile("s_waitcnt vmcnt(0)" ::: "memory");
        } else {
            XB_SPIN(xb_ld(&bar[XB_XGEN(b.x)]) == gen, bar);
            __builtin_amdgcn_fence(__ATOMIC_ACQUIRE, "agent");
            asm volatile("s_waitcnt vmcnt(0)" ::: "memory");
        }
    }
    __syncthreads();
}


__device__ __forceinline__ void grid_bar(unsigned* ctr, unsigned target) {
    __syncthreads();
    if (threadIdx.x == 0) {
        __builtin_amdgcn_fence(__ATOMIC_RELEASE, "agent");
        __hip_atomic_fetch_add(ctr, 1u, __ATOMIC_RELAXED, __HIP_MEMORY_SCOPE_AGENT);
        while (__hip_atomic_load(ctr, __ATOMIC_RELAXED, __HIP_MEMORY_SCOPE_AGENT) < target) __builtin_amdgcn_s_sleep(2);
        __builtin_amdgcn_fence(__ATOMIC_ACQUIRE, "agent");
    }
    __syncthreads();
}

namespace pg8 {
constexpr int BM = 256, BK = 64, HALF = 128, HTB = HALF * BK * 2, STAGE_BYTES = 8 * HTB, NXCD = 8, WGM = 8;
__host__ __device__ __forceinline__ int lds_byte(int r, int c) { const int st = (r >> 4) * 2 + (c >> 5), rr = r & 15, cc = c & 31, ob = rr * 64 + cc * 2; return st * 1024 + (ob ^ (((ob >> 9) & 1) << 5)); }
__host__ __device__ __forceinline__ void stage_rc(int b, int& R, int& C) { const int st = b / 1024, sb = b % 1024, swz = sb ^ (((sb >> 9) & 1) << 5); R = (st >> 1) * 16 + swz / 64; C = (st & 1) * 32 + (swz % 64) / 2; }
__host__ __device__ __forceinline__ int perm32(int rho) { const int n = rho >> 4, i = rho & 15; return 8 * (i >> 2) + 4 * n + (i & 3); }
struct Unit { int pm, pn, kz, nt; };
struct Gemm { const bf16_t* A; const bf16_t* Bt; int lda, ldb; };
struct StaticOrder {
    int nM, nN, nwg, G, c, nt;
    __device__ void init(int M, int N, int G_, int c_, int nt_) { nM = M / BM; nN = N / BM; nwg = nM * nN; G = G_; c = c_; nt = nt_; }
    __device__ bool next(int i, Unit& u) const {
        const long L = (long)i * G + c; if (L >= nwg) return false;
        int wgid = (int)L; { const int q = nwg / NXCD, r = nwg % NXCD, xcd = wgid % NXCD, off = wgid / NXCD; wgid = (xcd < r ? xcd * (q + 1) : r * (q + 1) + (xcd - r) * q) + off; }
        const int nig = WGM * nN, gid = wgid / nig, fm = gid * WGM, gsz = (nM - fm) < WGM ? (nM - fm) : WGM;
        u.pm = fm + ((wgid % nig) % gsz); u.pn = (wgid % nig) / gsz; u.kz = 0; u.nt = nt; return true;
    }
};
struct SplitKOrder {
    int nN, nz, G, c, nt;
    __device__ bool next(int i, Unit& u) const { const int L = i * G + c; if (L >= nN * nz) return false; u.pm = 0; u.pn = L % nN; u.kz = L / nN; u.nt = nt; return true; }
};
struct PromptSampleOrder {
    int G, c, ntfull, nz;
    __device__ bool next(int i, Unit& u) const {
        const int L = i * G + c; if (L >= 256 + 16 * nz) return false;
        if (L < 256) { int wgid = L; { const int q = 256 / NXCD, xcd = wgid % NXCD, off = wgid / NXCD; wgid = xcd * q + off; }
            const int nig = WGM * 8, gid = wgid / nig, fm = gid * WGM; u.pm = fm + ((wgid % nig) % WGM); u.pn = (wgid % nig) / WGM; u.kz = 0; u.nt = ntfull; }
        else { const int idx = L - 256; u.pn = idx & 7; u.pm = 32 + ((idx >> 3) & 1); u.kz = idx >> 4; u.nt = ntfull / nz; }
        return true; }
};

template <class Epi, class Sched>
__device__ __forceinline__ void gemm_phase(LAS unsigned char* lds, const Gemm g, const Sched& S, const Epi& E) {
    const int tid = threadIdx.x, wid = __builtin_amdgcn_readfirstlane(tid >> 6), lane = tid & 63, wr = wid >> 2, wc = wid & 3, fr = lane & 15, fq = lane >> 4;
    unsigned voffA[2], voffB[2];
#pragma unroll
    for (int i = 0; i < 2; ++i) { int R, C; stage_rc(tid * 16 + i * 8192, R, C); const int Rb = Epi::PERM ? ((R & ~31) + perm32(R & 31)) : R;
        voffA[i] = (unsigned)(R * g.lda + C) * 2u; voffB[i] = (unsigned)(Rb * g.ldb + C) * 2u; }
    const size_t kstep = (size_t)(BK * 2);
    const size_t hstepA = (size_t)HALF * g.lda * 2, hstepB = (size_t)HALF * g.ldb * 2;
    const size_t tstepA = 2 * hstepA, tstepB = 2 * hstepB;
    const unsigned ldsw = (unsigned)wid * 1024u;
    const int aoff = lds_byte(wr * 64 + fr, fq * 8), boff = lds_byte(wc * 32 + fr, fq * 8);
#define PG8_SA(b, h) (((b) * 2 + (h)) * HTB)
#define PG8_SB(b, h) ((4 + (b) * 2 + (h)) * HTB)
#define PG8_STAGE(bufoff, gbase, voff) do { _Pragma("unroll") for (int _i = 0; _i < 2; ++_i) \
        __builtin_amdgcn_global_load_lds((const unsigned*)((const char*)(gbase) + (voff)[_i]), (LAS unsigned*)(lds + (bufoff) + ldsw + _i * 8192), 16, 0, 0); } while (0)
#define PG8_LDA(dst, b, h) do { _Pragma("unroll") for (int m = 0; m < 4; ++m) _Pragma("unroll") for (int k = 0; k < 2; ++k) dst[m][k] = *(const LAS bf16x8*)(lds + PG8_SA(b, h) + aoff + m * 2048 + k * 1024); } while (0)
#define PG8_LDB(dst, b, h) do { _Pragma("unroll") for (int n = 0; n < 2; ++n) _Pragma("unroll") for (int k = 0; k < 2; ++k) dst[n][k] = *(const LAS bf16x8*)(lds + PG8_SB(b, h) + boff + n * 2048 + k * 1024); } while (0)
#define PG8_MMA(ai, bj, At, Bt) do { __builtin_amdgcn_s_setprio(1); _Pragma("unroll") for (int m = 0; m < 4; ++m) _Pragma("unroll") for (int n = 0; n < 2; ++n) _Pragma("unroll") for (int k = 0; k < 2; ++k) \
        acc[ai][bj][m][n] = __builtin_amdgcn_mfma_f32_16x16x32_bf16(Bt[n][k], At[m][k], acc[ai][bj][m][n], 0, 0, 0); __builtin_amdgcn_s_setprio(0); } while (0)
#define PG8_WAIT_V(n) asm volatile("s_waitcnt vmcnt(" #n ")" ::: "memory")
#define PG8_WAIT_L(n) asm volatile("s_waitcnt lgkmcnt(" #n ")" ::: "memory")
#define PG8_BAR __builtin_amdgcn_s_barrier()
#define PG8_SCHED __builtin_amdgcn_sched_barrier(0)
    Unit cur, nxt; int ui = 0;
    if (!S.next(0, cur)) return;
    f32x4 acc[2][2][4][2];
#pragma unroll
    for (int a = 0; a < 2; ++a)
#pragma unroll
        for (int b = 0; b < 2; ++b)
#pragma unroll
            for (int m = 0; m < 4; ++m)
#pragma unroll
                for (int n = 0; n < 2; ++n) acc[a][b][m][n] = (f32x4){0.f, 0.f, 0.f, 0.f};
    bf16x8 At[4][2], B0[2][2], B1[2][2];
    const char* cA = (const char*)g.A + (size_t)cur.pm * tstepA + (size_t)cur.kz * cur.nt * (BK * 2); const char* cB = (const char*)g.Bt + (size_t)cur.pn * tstepB + (size_t)cur.kz * cur.nt * (BK * 2);
    PG8_STAGE(PG8_SB(0, 0), cB, voffB); PG8_STAGE(PG8_SB(0, 1), cB + hstepB, voffB); PG8_STAGE(PG8_SA(0, 0), cA, voffA); PG8_STAGE(PG8_SA(0, 1), cA + hstepA, voffA);
    if (wr == 1) PG8_BAR;
    PG8_WAIT_V(2); PG8_BAR;
    PG8_STAGE(PG8_SB(1, 0), cB + kstep, voffB); PG8_STAGE(PG8_SA(1, 0), cA + kstep, voffA); PG8_STAGE(PG8_SB(1, 1), cB + hstepB + kstep, voffB);
    PG8_WAIT_V(6); PG8_BAR;
    for (;;) {
        const bool has_next = S.next(ui + 1, nxt);
        const char* nA = has_next ? (const char*)g.A + (size_t)nxt.pm * tstepA + (size_t)nxt.kz * nxt.nt * (BK * 2) : cA; const char* nB = has_next ? (const char*)g.Bt + (size_t)nxt.pn * tstepB + (size_t)nxt.kz * nxt.nt * (BK * 2) : cB;
        const int nt = cur.nt;
        for (int t = 0; t < nt; t += 2) {
            const bool last = (t == nt - 2);
            const char* a1 = cA + (size_t)(t + 1) * kstep;
            const char* a2 = last ? nA : cA + (size_t)(t + 2) * kstep; const char* b2 = last ? nB : cB + (size_t)(t + 2) * kstep;
            const char* a3 = a2 + kstep; const char* b3 = b2 + kstep;
            PG8_LDB(B0, 0, 0); PG8_LDB(B1, 0, 1); PG8_SCHED; PG8_LDA(At, 0, 0); PG8_STAGE(PG8_SA(1, 1), a1 + hstepA, voffA);
            PG8_WAIT_V(8); PG8_WAIT_L(0); PG8_BAR; PG8_MMA(0, 0, At, B0); PG8_MMA(0, 1, At, B1); PG8_BAR; PG8_SCHED;
            PG8_LDA(At, 0, 1); PG8_STAGE(PG8_SB(0, 0), b2, voffB); PG8_STAGE(PG8_SB(0, 1), b2 + hstepB, voffB); PG8_STAGE(PG8_SA(0, 0), a2, voffA);
            PG8_WAIT_V(8); PG8_WAIT_L(0); PG8_BAR; PG8_MMA(1, 0, At, B0); PG8_MMA(1, 1, At, B1); PG8_BAR; PG8_SCHED;
            PG8_LDB(B0, 1, 0); PG8_LDB(B1, 1, 1); PG8_SCHED; PG8_LDA(At, 1, 0); PG8_STAGE(PG8_SA(0, 1), a2 + hstepA, voffA);
            PG8_WAIT_V(8); PG8_WAIT_L(0); PG8_BAR; PG8_MMA(0, 0, At, B0); PG8_MMA(0, 1, At, B1); PG8_BAR; PG8_SCHED;
            PG8_LDA(At, 1, 1); PG8_STAGE(PG8_SB(1, 0), b3, voffB); PG8_STAGE(PG8_SB(1, 1), b3 + hstepB, voffB); PG8_STAGE(PG8_SA(1, 0), a3, voffA);
            PG8_WAIT_V(8); PG8_WAIT_L(0); PG8_BAR; PG8_MMA(1, 0, At, B0); PG8_MMA(1, 1, At, B1); PG8_BAR; PG8_SCHED;
        }
        if (wr == 0) PG8_BAR;
        E(acc, cur, wr, wc, fr, fq);
        if (!has_next) break;
#pragma unroll
        for (int a = 0; a < 2; ++a)
#pragma unroll
            for (int b = 0; b < 2; ++b)
#pragma unroll
                for (int m = 0; m < 4; ++m)
#pragma unroll
                    for (int n = 0; n < 2; ++n) acc[a][b][m][n] = (f32x4){0.f, 0.f, 0.f, 0.f};
        cur = nxt; cA = nA; cB = nB; ++ui;
        if (wr == 1) PG8_BAR;
    }
    PG8_WAIT_V(0);
    PG8_BAR;
#undef PG8_SA
#undef PG8_SB
#undef PG8_STAGE
#undef PG8_LDA
#undef PG8_LDB
#undef PG8_MMA
#undef PG8_WAIT_V
#undef PG8_WAIT_L
#undef PG8_BAR
#undef PG8_SCHED
}

struct EpiMod {
    static constexpr bool PERM = false;
    float* mod; const float* bias;
    __device__ __forceinline__ void operator()(const f32x4 (&acc)[2][2][4][2], const Unit& u, int wr, int wc, int fr, int fq) const {
        const int col0 = u.pn * BM + wc * 32 + 4 * fq;
        f32x4 bv[2][2];
#pragma unroll
        for (int bj = 0; bj < 2; ++bj)
#pragma unroll
            for (int n = 0; n < 2; ++n) bv[bj][n] = *(const f32x4*)(bias + col0 + bj * HALF + n * 16);
#pragma unroll
        for (int ai = 0; ai < 2; ++ai)
#pragma unroll
            for (int m = 0; m < 4; ++m) { const int row = ai * HALF + wr * 64 + m * 16 + fr; if (row < 129) {
#pragma unroll
                for (int bj = 0; bj < 2; ++bj)
#pragma unroll
                    for (int n = 0; n < 2; ++n) { const int c = col0 + bj * HALF + n * 16; *(f32x4*)(mod + (size_t)row * NMOD + c) = acc[ai][bj][m][n] + bv[bj][n]; } } }
    }
};
struct EpiBf16 {
    static constexpr bool PERM = true;
    bf16_t* O; int ldc;
    __device__ __forceinline__ void operator()(const f32x4 (&acc)[2][2][4][2], const Unit& u, int wr, int wc, int fr, int fq) const {
        const int row0 = u.pm * BM + wr * 64 + fr, col0 = u.pn * BM + wc * 32 + 8 * fq;
#pragma unroll
        for (int ai = 0; ai < 2; ++ai)
#pragma unroll
            for (int m = 0; m < 4; ++m) { bf16_t* rowp = O + (size_t)(row0 + ai * HALF + m * 16) * ldc + col0;
#pragma unroll
                for (int bj = 0; bj < 2; ++bj) { const f32x4 v0 = acc[ai][bj][m][0], v1 = acc[ai][bj][m][1];
                    u32x4 w; w.x = cvt_pk_bf16(v0[0], v0[1]); w.y = cvt_pk_bf16(v0[2], v0[3]); w.z = cvt_pk_bf16(v1[0], v1[1]); w.w = cvt_pk_bf16(v1[2], v1[3]);
                    *(u32x4*)(rowp + bj * HALF) = w; } }
    }
};
struct EpiGU {
    static constexpr bool PERM = true;
    bf16_t* O; int ldc;
    __device__ __forceinline__ void operator()(const f32x4 (&acc)[2][2][4][2], const Unit& u, int wr, int wc, int fr, int fq) const {
        const int row0 = u.pm * BM + wr * 64 + fr, col0 = u.pn * HALF + wc * 32 + 8 * fq;
#pragma unroll
        for (int ai = 0; ai < 2; ++ai)
#pragma unroll
            for (int m = 0; m < 4; ++m) { bf16_t* rowp = O + (size_t)(row0 + ai * HALF + m * 16) * ldc + col0;
                float r[8];
#pragma unroll
                for (int n = 0; n < 2; ++n)
#pragma unroll
                    for (int e = 0; e < 4; ++e) { const float gt = acc[ai][0][m][n][e], up = acc[ai][1][m][n][e]; r[n * 4 + e] = gt * __builtin_amdgcn_rcpf(1.f + __expf(-gt)) * up; }
                *(u32x4*)rowp = pack8(r); }
    }
};
__device__ __forceinline__ void store_partials(const f32x4 (&acc)[2][2][4][2], const Unit& u, int row0, int col0, const float* gate, float* part) {
    int poff = (u.kz * MS + (row0 - SP)) * D + col0; asm volatile("" : "+v"(poff));
#pragma unroll
    for (int am = 0; am < 4; ++am) { f32x4 gv[2][2][2];
#pragma unroll
        for (int m2 = 0; m2 < 2; ++m2) { const int rr = row0 - SP + (am >> 1) * HALF + ((am & 1) * 2 + m2) * 16; const int go = (rr >> 2) * NMOD + col0;
#pragma unroll
            for (int bj = 0; bj < 2; ++bj)
#pragma unroll
                for (int n = 0; n < 2; ++n) gv[m2][bj][n] = *(const f32x4*)(gate + (go + bj * HALF + n * 16)); }
#pragma unroll
        for (int m2 = 0; m2 < 2; ++m2) { const int po = poff + ((am >> 1) * HALF + ((am & 1) * 2 + m2) * 16) * D;
#pragma unroll
            for (int bj = 0; bj < 2; ++bj)
#pragma unroll
                for (int n = 0; n < 2; ++n) *(f32x4*)(part + (po + bj * HALF + n * 16)) = gv[m2][bj][n] * acc[am >> 1][bj][(am & 1) * 2 + m2][n]; } }
}
struct EpiRes {
    static constexpr bool PERM = false;
    float* out; const float* res0; const float* res1; const float* gate; float* part;
    __device__ __forceinline__ void operator()(const f32x4 (&acc)[2][2][4][2], const Unit& u, int wr, int wc, int fr, int fq) const {
        const int row0 = u.pm * BM + wr * 64 + fr, col0 = u.pn * BM + wc * 32 + 4 * fq;
        if (u.pm >= 32) { store_partials(acc, u, row0, col0, gate, part); return; }
        f32x4 gv[2][2];
#pragma unroll
        for (int bj = 0; bj < 2; ++bj)
#pragma unroll
            for (int n = 0; n < 2; ++n) gv[bj][n] = *(const f32x4*)(gate + (size_t)128 * NMOD + col0 + bj * HALF + n * 16);
        int roff = row0 * D + col0; asm volatile("" : "+v"(roff));
#pragma unroll
        for (int am = 0; am < 4; ++am) { f32x4 rv[2][2][2];
#pragma unroll
            for (int m2 = 0; m2 < 2; ++m2)
#pragma unroll
                for (int bj = 0; bj < 2; ++bj)
#pragma unroll
                    for (int n = 0; n < 2; ++n) rv[m2][bj][n] = *(const f32x4*)(res0 + (roff + ((am >> 1) * HALF + ((am & 1) * 2 + m2) * 16) * D + bj * HALF + n * 16));
#pragma unroll
            for (int m2 = 0; m2 < 2; ++m2)
#pragma unroll
                for (int bj = 0; bj < 2; ++bj)
#pragma unroll
                    for (int n = 0; n < 2; ++n) *(f32x4*)(out + (roff + ((am >> 1) * HALF + ((am & 1) * 2 + m2) * 16) * D + bj * HALF + n * 16)) = rv[m2][bj][n] + gv[bj][n] * acc[am >> 1][bj][(am & 1) * 2 + m2][n]; }
    }
};
struct EpiResNorm {
    static constexpr bool PERM = false;
    float* out; const float* res0; const float* gate; float* part; const float* nw; float* ssq; unsigned* pcnt; LAS float* red;
    __device__ __forceinline__ void operator()(const f32x4 (&acc)[2][2][4][2], const Unit& u, int wr, int wc, int fr, int fq) const {
        const int row0 = u.pm * BM + wr * 64 + fr, col0 = u.pn * BM + wc * 32 + 4 * fq, tid = threadIdx.x;
        if (u.pm >= 32) { store_partials(acc, u, row0, col0, gate, part); return; }
        const float* gp = gate + (size_t)128 * NMOD;
        int roff = row0 * D + col0; asm volatile("" : "+v"(roff));
#pragma unroll
        for (int ai = 0; ai < 2; ++ai)
#pragma unroll
            for (int m = 0; m < 4; ++m) { const int ro = roff + (ai * HALF + m * 16) * D; float ps = 0.f;
#pragma unroll
                for (int bj = 0; bj < 2; ++bj)
#pragma unroll
                    for (int n = 0; n < 2; ++n) { const int o = bj * HALF + n * 16; const f32x4 rv = *(const f32x4*)(res0 + (ro + o)), gv = *(const f32x4*)(gp + (col0 + o));
                        const f32x4 v = rv + gv * acc[ai][bj][m][n]; ps += v[0] * v[0] + v[1] * v[1] + v[2] * v[2] + v[3] * v[3]; }
                ps += __shfl_xor(ps, 16); ps += __shfl_xor(ps, 32);
                if (fq == 0) red[(ai * HALF + wr * 64 + m * 16 + fr) * 4 + wc] = ps; }
        __syncthreads();
        if (tid < 256) { const f32x4 r4 = *(const LAS f32x4*)(red + tid * 4);
            __hip_atomic_store(ssq + (size_t)(u.pm * 8 + u.pn) * 256 + tid, r4[0] + r4[1] + r4[2] + r4[3], __ATOMIC_RELAXED, __HIP_MEMORY_SCOPE_AGENT); }
        asm volatile("s_waitcnt vmcnt(0)" ::: "memory");
        __syncthreads();
        if (tid == 0) { __hip_atomic_fetch_add(pcnt + u.pm, 1u, __ATOMIC_RELAXED, __HIP_MEMORY_SCOPE_AGENT); unsigned sp = 0;
            while (__hip_atomic_load(pcnt + u.pm, __ATOMIC_RELAXED, __HIP_MEMORY_SCOPE_AGENT) < 8u && ++sp < (1u << 22)) __builtin_amdgcn_s_sleep(1); }
        __syncthreads();
        if (tid < 256) { float tot = 0.f; const float* sp = ssq + (size_t)(u.pm * 8) * 256 + tid;
#pragma unroll 1
            for (int j = 0; j < 8; ++j) { tot += __hip_atomic_load(sp, __ATOMIC_RELAXED, __HIP_MEMORY_SCOPE_AGENT); sp += 256; }
            red[1024 + tid] = rsqrtf(tot * (1.f / D) + EPS); }
        __syncthreads();
        int woff = row0 * D + col0; asm volatile("" : "+v"(woff));
        f32x4 gw[2][2], ww[2][2];
#pragma unroll
        for (int bj = 0; bj < 2; ++bj)
#pragma unroll
            for (int n = 0; n < 2; ++n) { gw[bj][n] = *(const f32x4*)(gp + (col0 + bj * HALF + n * 16)); ww[bj][n] = *(const f32x4*)(nw + (col0 + bj * HALF + n * 16)); }
#pragma unroll
        for (int am = 0; am < 4; ++am) { f32x4 rv[2][2][2]; float rr[2];
#pragma unroll
            for (int m2 = 0; m2 < 2; ++m2) { rr[m2] = red[1024 + (am >> 1) * HALF + wr * 64 + ((am & 1) * 2 + m2) * 16 + fr];
#pragma unroll
                for (int bj = 0; bj < 2; ++bj)
#pragma unroll
                    for (int n = 0; n < 2; ++n) rv[m2][bj][n] = *(const f32x4*)(res0 + (woff + ((am >> 1) * HALF + ((am & 1) * 2 + m2) * 16) * D + bj * HALF + n * 16)); }
#pragma unroll
            for (int m2 = 0; m2 < 2; ++m2)
#pragma unroll
                for (int bj = 0; bj < 2; ++bj)
#pragma unroll
                    for (int n = 0; n < 2; ++n) *(f32x4*)(out + (woff + ((am >> 1) * HALF + ((am & 1) * 2 + m2) * 16) * D + bj * HALF + n * 16)) = (rv[m2][bj][n] + gw[bj][n] * acc[am >> 1][bj][(am & 1) * 2 + m2][n]) * rr[m2] * ww[bj][n]; }
    }
};
}

struct Frame {
    LAS unsigned char* lds;
    int tid, lane, wave, G, bid;
    const float* in[23];
    float* out; unsigned char* ws;
};

struct TileDesc { const float* src; bf16_t* dst; int ldn, K, k0, n0, kind; };
__device__ __forceinline__ TileDesc tile_desc(const Frame& F, int t) {
    unsigned char* ws = F.ws; TileDesc d; int NT, idx; d.kind = 0;
    if (t < 1536) { d.src = F.in[12]; d.ldn = NMOD; d.K = D; NT = 48; idx = t; d.dst = (bf16_t*)(ws + WS_WADA); }
    else if (t < 2240) { d.src = F.in[14]; d.ldn = INW; d.K = D; NT = 22; idx = t - 1536; d.dst = (bf16_t*)(ws + WS_WIN); }
    else if (t < 2496) { d.src = F.in[19]; d.ldn = D; d.K = D; NT = 8; idx = t - 2240; d.dst = (bf16_t*)(ws + WS_WOUT); }
    else if (t < 3200) { d.src = F.in[20]; d.ldn = DFF; d.K = D; NT = 22; idx = t - 2496; d.dst = (bf16_t*)(ws + WS_WGU); d.kind = 1; }
    else if (t < 3904) { d.src = F.in[21]; d.ldn = DFF; d.K = D; NT = 22; idx = t - 3200; d.dst = (bf16_t*)(ws + WS_WGU); d.kind = 2; }
    else { d.src = F.in[22]; d.ldn = D; d.K = DFF; NT = 8; idx = t - 3904; d.dst = (bf16_t*)(ws + WS_WDN); }
    d.n0 = (idx % NT) * 256; d.k0 = (idx / NT) * 64; return d;
}
__device__ __forceinline__ void convert_tiles(const Frame& F, int tlo, int thi, int wb, int nw) {
    LAS float* tile = (LAS float*)F.lds;
    int t = tlo + wb; if (t >= thi) return;
    TileDesc d = tile_desc(F, t);
    f32x4 v[8];
#pragma unroll
    for (int i = 0; i < 8; ++i) v[i] = __builtin_nontemporal_load((const f32x4*)(d.src + (size_t)(d.k0 + i * 8 + F.wave) * d.ldn + d.n0 + F.lane * 4));
    for (;;) {
#pragma unroll
        for (int i = 0; i < 8; ++i) { LAS float* tp = tile + (i * 8 + F.wave) * 257 + F.lane * 4; tp[0] = v[i][0]; tp[1] = v[i][1]; tp[2] = v[i][2]; tp[3] = v[i][3]; }
        __syncthreads();
        const int tn = t + nw; const bool more = tn < thi; TileDesc dn = d;
        if (more) { dn = tile_desc(F, tn);
#pragma unroll
            for (int i = 0; i < 8; ++i) v[i] = __builtin_nontemporal_load((const f32x4*)(dn.src + (size_t)(dn.k0 + i * 8 + F.wave) * dn.ldn + dn.n0 + F.lane * 4)); }
#pragma unroll
        for (int it = 0; it < 4; ++it) { const int item = it * 512 + F.tid, n = item >> 3, kg = item & 7;
            float f[8];
#pragma unroll
            for (int j = 0; j < 8; ++j) f[j] = tile[(kg * 8 + j) * 257 + n];
            const int nn = d.n0 + n; const int row = d.kind == 0 ? nn : (((nn >> 7) << 8) + (nn & 127) + (d.kind == 2 ? 128 : 0));
            *(u32x4*)(d.dst + (size_t)row * d.K + d.k0 + kg * 8) = pack8(f); }
        __syncthreads();
        if (!more) break;
        t = tn; d = dn;
    }
}

__device__ __forceinline__ void p0_prologue(const Frame& F) {
    unsigned char* ws = F.ws;
    convert_tiles(F, 0, 2496, F.bid, F.G);
    const int gt = F.bid * 512 + F.tid, GT = F.G * 512;
    { bf16_t* sc = (bf16_t*)(ws + WS_SILU);
      for (int i = gt; i < 256 * D / 2; i += GT) { const int r = (i * 2) >> 11, c = (i * 2) & 2047; float a = 0.f, b = 0.f;
          if (r < 128) { a = F.in[8][r * D + c]; b = F.in[8][r * D + c + 1]; } else if (r == 128) { a = F.in[7][c]; b = F.in[7][c + 1]; }
          a = a / (1.f + expf(-a)); b = b / (1.f + expf(-b));
          *(unsigned*)(sc + (size_t)i * 2) = cvt_pk_bf16(a, b); } }
    { float* rt = (float*)(ws + WS_ROPE);
      for (int i = gt; i < 8196 * 8; i += GT) { const int pi = i >> 3, f = i & 7; const int pos = pi < SP ? pi : 16384 + (pi - SP);
          const float inv = f == 0 ? 1.0f : f == 1 ? 0.1939227432012558f : f == 2 ? 0.03760603070259094f : f == 3 ? 0.007292664609849453f : f == 4 ? 0.0014142135623842478f : f == 5 ? 0.00027424818836152554f : f == 6 ? 5.318296098266728e-05f : 1.0313386155758053e-05f;
          const float ang = (float)pos * inv; const double a = (double)ang; const double k = rint(a * 0.15915494309189535); const float r = (float)(a - k * 6.283185307179586);
          rt[pi * 16 + f] = cosf(r); rt[pi * 16 + 8 + f] = sinf(r); } }
    { float* wg = (float*)(ws + WS_WG); for (int i = gt; i < 8 * D; i += GT) { const int j = i >> 11, c = i & 2047; wg[i] = F.in[14][(size_t)c * INW + NIN + j]; } }
}

__device__ __forceinline__ void kvwin_copy(const Frame& F, int gt, int GT) {
    const int per = 124 * 64;
    for (int i0 = gt; i0 < NB * per; i0 += 4 * GT) { f32x4 a[4], b[4]; size_t so[4], dof[4];
#pragma unroll
        for (int u = 0; u < 4; ++u) { const int i = i0 + u * GT; const int ii = i < NB * per ? i : 0; const int bb = ii / per, o = ii - bb * per; so[u] = (size_t)bb * 8192 + 256 + o; dof[u] = (size_t)bb * 8192 + o;
            a[u] = __builtin_nontemporal_load((const f32x4*)F.in[2] + so[u]); b[u] = __builtin_nontemporal_load((const f32x4*)F.in[3] + so[u]); }
#pragma unroll
        for (int u = 0; u < 4; ++u) { if (i0 + u * GT < NB * per) { __builtin_nontemporal_store(a[u], (f32x4*)(F.out + O_KWS) + dof[u]); __builtin_nontemporal_store(b[u], (f32x4*)(F.out + O_VWS) + dof[u]); } } }
}

template <bool GATES>
__device__ __forceinline__ void norm_mod_phase(const Frame& F, const float* src0, const float* src1, const float* nw, int sh_off, int sc_off, int nparts, float* x1out) {
    const float* mod = (const float*)(F.ws + WS_MOD);
    bf16_t* H = (bf16_t*)(F.ws + WS_H);
    LAS float* wg = (LAS float*)F.lds;
    if (GATES) { const f32x4* s = (const f32x4*)(F.ws + WS_WG); for (int i = F.tid; i < 8 * D / 4; i += 512) ((LAS f32x4*)wg)[i] = s[i]; __syncthreads(); }
    f32x4 av[8], shv[8];
    { const float* mr = mod + (size_t)128 * NMOD;
#pragma unroll
      for (int i = 0; i < 8; ++i) { const int c4 = i * 64 + F.lane; const f32x4 w = ((const f32x4*)nw)[c4], sc = ((const f32x4*)(mr + sc_off))[c4]; shv[i] = ((const f32x4*)(mr + sh_off))[c4]; av[i] = w * (sc + 1.f); } }
    for (int r = F.bid * 8 + F.wave; r < MTOT; r += F.G * 8) {
        const float* xr = r < SP ? src0 + (size_t)r * D : src1 + (size_t)(r - SP) * D;
        f32x4 xv[8]; float ss = 0.f;
#pragma unroll
        for (int i = 0; i < 8; ++i) xv[i] = ((const f32x4*)xr)[i * 64 + F.lane];
        if (r >= SP) { const float* mr = mod + (size_t)((r - SP) >> 2) * NMOD;
#pragma unroll
            for (int i = 0; i < 8; ++i) { const int c4 = i * 64 + F.lane; const f32x4 w = ((const f32x4*)nw)[c4], sc = ((const f32x4*)(mr + sc_off))[c4]; shv[i] = ((const f32x4*)(mr + sh_off))[c4]; av[i] = w * (sc + 1.f); }
            if (nparts > 0) {
                for (int z = 0; z < nparts; ++z) { const f32x4* pp = (const f32x4*)(F.ws + WS_PART) + ((size_t)z * MS + (r - SP)) * (D / 4);
#pragma unroll
                    for (int i = 0; i < 8; ++i) xv[i] += pp[i * 64 + F.lane]; }
#pragma unroll
                for (int i = 0; i < 8; ++i) ((f32x4*)(x1out + (size_t)(r - SP) * D))[i * 64 + F.lane] = xv[i]; } }
#pragma unroll
        for (int i = 0; i < 8; ++i) ss += xv[i][0] * xv[i][0] + xv[i][1] * xv[i][1] + xv[i][2] * xv[i][2] + xv[i][3] * xv[i][3];
        ss = wave_sum(ss);
        const float rstd = rsqrtf(ss * (1.f / D) + EPS);
        float g[8];
#pragma unroll
        for (int j = 0; j < 8; ++j) g[j] = 0.f;
#pragma unroll
        for (int i = 0; i < 8; ++i) { const int c4 = i * 64 + F.lane;
            f32x4 h;
#pragma unroll
            for (int e = 0; e < 4; ++e) h[e] = (xv[i][e] * rstd) * av[i][e] + shv[i][e];
            u32x2 pk; pk.x = cvt_pk_bf16(h[0], h[1]); pk.y = cvt_pk_bf16(h[2], h[3]);
            *(u32x2*)(H + (size_t)r * D + c4 * 4) = pk;
            if (GATES) {
#pragma unroll
                for (int j = 0; j < 8; ++j) { const f32x4 wv = ((const LAS f32x4*)(wg + j * D))[c4]; g[j] += h[0] * wv[0] + h[1] * wv[1] + h[2] * wv[2] + h[3] * wv[3]; } } }
        if (GATES) {
#pragma unroll
            for (int j = 0; j < 8; ++j) g[j] = wave_sum(g[j]);
            if (F.lane == 0) { float* gp = (float*)(F.ws + WS_GATES) + (size_t)r * 8;
                *(f32x4*)gp = (f32x4){g[0], g[1], g[2], g[3]}; *(f32x4*)(gp + 4) = (f32x4){g[4], g[5], g[6], g[7]}; } }
    }
    if (GATES) __syncthreads();
}

__device__ __forceinline__ void mlstm_scan(const Frame& F, int hh) {
    LAS float* sB = (LAS float*)F.lds;
    LAS float* sW = sB + SP;
    LAS float* sM = sW + SP;
    LAS float* tot = sM + SP;
    const float* gates = (const float*)(F.ws + WS_GATES);
    const float big = F.in[15][hh], bfg = F.in[16][hh];
    float cB = 0.f, cM = -INFINITY;
    for (int it = 0; it < 16; ++it) { const int t = F.wave * 1024 + it * 64 + F.lane;
        const float li = gates[(size_t)t * 8 + hh] + big; float v = logsigmoid_(gates[(size_t)t * 8 + 4 + hh] + bfg);
#pragma unroll
        for (int d = 1; d < 64; d <<= 1) { const float o = __shfl_up(v, d); if (F.lane >= d) v += o; }
        const float Bl = cB + v; const float wl = li - Bl; float mx = wl;
#pragma unroll
        for (int d = 1; d < 64; d <<= 1) { const float o = __shfl_up(mx, d); if (F.lane >= d) mx = fmaxf(mx, o); }
        mx = fmaxf(mx, cM);
        sB[t] = Bl; sW[t] = wl; sM[t] = mx;
        cB = __shfl(Bl, 63); cM = __shfl(mx, 63); }
    if (F.lane == 0) { tot[F.wave] = cB; tot[8 + F.wave] = cM; }
    __syncthreads();
    float Boff = 0.f, Min = 0.f;
    for (int w = 0; w < F.wave; ++w) { Min = fmaxf(Min, tot[8 + w] - Boff); Boff += tot[w]; }
    float* BC = (float*)(F.ws + WS_BC) + hh * SP; float* BW = (float*)(F.ws + WS_BW) + hh * SP; float* MR = (float*)(F.ws + WS_MR) + hh * SP;
    for (int it = 0; it < 16; ++it) { const int t = F.wave * 1024 + it * 64 + F.lane;
        const float B = Boff + sB[t], W = sW[t] - Boff, M = fmaxf(Min, sM[t] - Boff);
        BC[t] = B; BW[t] = W; MR[t] = M;
        if (t == SP - 1) F.out[O_MP + hh] = B + M; }
    __syncthreads();
}

__device__ __forceinline__ void attn_prompt_unit(const Frame& F, int qb, int g) {
    const bf16_t* P = (const bf16_t*)(F.ws + WS_P); const float* rope = (const float*)(F.ws + WS_ROPE);
    bf16_t* MIX = (bf16_t*)(F.ws + WS_MIX);
    LAS bf16_t* Ks = (LAS bf16_t*)F.lds;
    LAS bf16_t* Vt = Ks + 192 * 72;
    LAS bf16_t* Pw = Vt + 64 * 200 + F.wave * (16 * 200);
    const int q0 = qb * 64, lane = F.lane, fr = lane & 15, kg = lane >> 4, dgs = F.tid & 7;
    const int hq = g * 4 + (F.wave & 3), qh = F.wave >> 2;
    u32x4 qn0, qn1, qno; f32x4 qnc[4];
#define ATT_QLOAD(qtx) do { const int trx = q0 + qh * 32 + (qtx) * 16 + fr; const bf16_t* rowx = P + (size_t)trx * NIN + C_AQ + hq * 64; qn0 = *(const u32x4*)(rowx + kg * 8); qn1 = *(const u32x4*)(rowx + 32 + kg * 8); \
        if (kg < 2) { qno = *(const u32x4*)(rowx + (kg ^ 1) * 8); _Pragma("unroll") for (int k = 0; k < 4; ++k) qnc[k] = *(const f32x4*)(rope + (size_t)trx * 16 + 4 * k); } } while (0)
    ATT_QLOAD(0);
    u32x4 kv[3], ov[3], vv[2][2]; f32x4 kc[3][4];
#pragma unroll
    for (int it = 0; it < 3; ++it) { const int key = (it * 512 + F.tid) >> 3, kp = q0 - 128 + key; kv[it] = *(const u32x4*)(P + (size_t)(kp < 0 ? 0 : kp) * NIN + C_AK + g * 64 + dgs * 8); }
    if (dgs < 2) {
#pragma unroll
        for (int it = 0; it < 3; ++it) { const int key = (it * 512 + F.tid) >> 3, kp = q0 - 128 + key, kpc = kp < 0 ? 0 : kp; ov[it] = *(const u32x4*)(P + (size_t)kpc * NIN + C_AK + g * 64 + (dgs ^ 1) * 8);
#pragma unroll
            for (int k = 0; k < 4; ++k) kc[it][k] = *(const f32x4*)(rope + (size_t)kpc * 16 + 4 * k); } }
#pragma unroll
    for (int it = 0; it < 2; ++it) { const int item = it * 512 + F.tid; const int k2 = item < 768 ? item % 96 : 0, dg = item < 768 ? item / 96 : 0, kp = q0 - 128 + 2 * k2;
        const bf16_t* row = P + (size_t)(kp < 0 ? 0 : kp) * NIN + C_AV + g * 64 + dg * 8; vv[it][0] = *(const u32x4*)row; vv[it][1] = *(const u32x4*)(row + NIN); }
#pragma unroll
    for (int it = 0; it < 3; ++it) { const int key = (it * 512 + F.tid) >> 3, kp = q0 - 128 + key; u32x4 k4 = kv[it];
        if (dgs < 2) { float a[8], b[8]; unpack8(k4, a); unpack8(ov[it], b);
#pragma unroll
            for (int i = 0; i < 8; ++i) { const float cs = kc[it][i >> 2][i & 3], sn = kc[it][2 + (i >> 2)][i & 3]; a[i] = (dgs == 0) ? a[i] * cs - b[i] * sn : a[i] * cs + b[i] * sn; }
            k4 = pack8(a); }
        if (kp < 0) k4 = (u32x4){0u, 0u, 0u, 0u};
        *(LAS u32x4*)(Ks + key * 72 + dgs * 8) = k4; }
#pragma unroll
    for (int it = 0; it < 2; ++it) { const int item = it * 512 + F.tid; if (item < 768) { const int k2 = item % 96, dg = item / 96, kp = q0 - 128 + 2 * k2;
        u32x4 v0 = vv[it][0], v1 = vv[it][1]; if (kp < 0) { v0 = (u32x4){0u, 0u, 0u, 0u}; v1 = v0; }
        unsigned w[8]; zip8(v0, v1, w);
#pragma unroll
        for (int i = 0; i < 8; ++i) *(LAS unsigned*)(Vt + (dg * 8 + i) * 200 + 2 * k2) = w[i]; } }
    __syncthreads();
    const float sink = F.in[17][hq];
    for (int qt = 0; qt < 2; ++qt) {
        const int tq = q0 + qh * 32 + qt * 16;
        bf16x8 qf[2];
        { u32x4 qv = qn0;
          if (kg < 2) { float a[8], b[8]; unpack8(qv, a); unpack8(qno, b);
#pragma unroll
              for (int i = 0; i < 8; ++i) { const float cs = qnc[i >> 2][i & 3], sn = qnc[2 + (i >> 2)][i & 3]; a[i] = (kg == 0) ? a[i] * cs - b[i] * sn : a[i] * cs + b[i] * sn; }
              qv = pack8(a); }
          qf[0] = __builtin_bit_cast(bf16x8, qv); qf[1] = __builtin_bit_cast(bf16x8, qn1); }
        if (qt == 0) ATT_QLOAD(1);
        f32x4 s[12];
#pragma unroll
        for (int kt = 0; kt < 12; ++kt) { s[kt] = (f32x4){0.f, 0.f, 0.f, 0.f};
#pragma unroll
            for (int ks = 0; ks < 2; ++ks) { const bf16x8 kf = *(const LAS bf16x8*)(Ks + (kt * 16 + fr) * 72 + ks * 32 + kg * 8);
                s[kt] = __builtin_amdgcn_mfma_f32_16x16x32_bf16(kf, qf[ks], s[kt], 0, 0, 0); } }
        const int qp = tq + fr; float m = sink;
#pragma unroll
        for (int kt = 0; kt < 12; ++kt)
#pragma unroll
            for (int j = 0; j < 4; ++j) { const int kp = q0 - 128 + kt * 16 + kg * 4 + j; const bool ok = (kp >= 0) && (kp <= qp) && (qp - kp < 128);
                const float v = ok ? s[kt][j] * 0.125f : -INFINITY; s[kt][j] = v; m = fmaxf(m, v); }
        m = fmaxf(m, __shfl_xor(m, 16)); m = fmaxf(m, __shfl_xor(m, 32));
        float sum = 0.f;
        asm volatile("" ::: "memory");
#pragma unroll
        for (int kt = 0; kt < 12; ++kt) {
#pragma unroll
            for (int j = 0; j < 4; ++j) { const float p = __expf(s[kt][j] - m); s[kt][j] = p; sum += p; }
            u32x2 pk; pk.x = cvt_pk_bf16(s[kt][0], s[kt][1]); pk.y = cvt_pk_bf16(s[kt][2], s[kt][3]);
            *(LAS u32x2*)(Pw + fr * 200 + kt * 16 + kg * 4) = pk; }
        asm volatile("" ::: "memory");
        sum += __shfl_xor(sum, 16); sum += __shfl_xor(sum, 32);
        const float linv = 1.f / (sum + __expf(sink - m));
        f32x4 o[4];
#pragma unroll
        for (int dt = 0; dt < 4; ++dt) o[dt] = (f32x4){0.f, 0.f, 0.f, 0.f};
#pragma unroll
        for (int kk = 0; kk < 6; ++kk) { const bf16x8 pf = *(const LAS bf16x8*)(Pw + fr * 200 + kk * 32 + kg * 8);
#pragma unroll
            for (int dt = 0; dt < 4; ++dt) { const bf16x8 vf = *(const LAS bf16x8*)(Vt + (dt * 16 + fr) * 200 + kk * 32 + kg * 8);
                o[dt] = __builtin_amdgcn_mfma_f32_16x16x32_bf16(vf, pf, o[dt], 0, 0, 0); } }
        { bf16_t* op = MIX + (size_t)(tq + fr) * D + hq * 64 + kg * 4;
#pragma unroll
          for (int dt = 0; dt < 4; ++dt) { u32x2 pk; pk.x = cvt_pk_bf16(o[dt][0] * linv, o[dt][1] * linv); pk.y = cvt_pk_bf16(o[dt][2] * linv, o[dt][3] * linv); *(u32x2*)(op + dt * 16) = pk; } }
    }
    __syncthreads();
}

#undef ATT_QLOAD
__device__ __forceinline__ void attn_sample_wave(const Frame& F, int unit) {
    const bf16_t* P = (const bf16_t*)(F.ws + WS_P); const float* rope = (const float*)(F.ws + WS_ROPE);
    bf16_t* MIX = (bf16_t*)(F.ws + WS_MIX);
    const int b = unit >> 4, hq = unit & 15, g = hq >> 2, lane = F.lane;
    LAS float* base = (LAS float*)F.lds + F.wave * 1408;
    LAS float* sq = base; LAS float* sk = base + 256; LAS float* sv = base + 512; LAS float* sp = base + 768;
    float q4[4], k4[4], v4[4], qo4[4], ko4[4], c4[4], s4[4];
#pragma unroll
    for (int t = 0; t < 4; ++t) { const bf16_t* row = P + (size_t)(SP + b * 4 + t) * NIN; const float* cs = rope + (size_t)(SP + t) * 16;
        q4[t] = bf2f(row[C_AQ + hq * 64 + lane]); k4[t] = bf2f(row[C_AK + g * 64 + lane]); v4[t] = bf2f(row[C_AV + g * 64 + lane]);
        qo4[t] = bf2f(row[C_AQ + hq * 64 + ((lane ^ 8) & 15)]); ko4[t] = bf2f(row[C_AK + g * 64 + ((lane ^ 8) & 15)]); c4[t] = cs[lane & 7]; s4[t] = cs[8 + (lane & 7)]; }
#pragma unroll
    for (int t = 0; t < 4; ++t) { float qv = q4[t], kv = k4[t]; const float vv = v4[t];
        if (lane < 16) { const float c = c4[t], sn = s4[t]; if (lane < 8) { qv = qv * c - qo4[t] * sn; kv = kv * c - ko4[t] * sn; } else { qv = qv * c + qo4[t] * sn; kv = kv * c + ko4[t] * sn; } }
        sq[t * 64 + lane] = qv * 0.125f; sk[t * 64 + lane] = kv; sv[t * 64 + lane] = vv;
        if ((hq & 3) == 0) { F.out[O_KWS + ((size_t)b * 128 + 124 + t) * 256 + g * 64 + lane] = kv; F.out[O_VWS + ((size_t)b * 128 + 124 + t) * 256 + g * 64 + lane] = vv; } }
    const float sink = F.in[17][hq];
    float sc[3][4];
#pragma unroll
    for (int kk = 0; kk < 3; ++kk) { const int kidx = kk * 64 + lane;
#pragma unroll
        for (int t = 0; t < 4; ++t) sc[kk][t] = 0.f;
        if (kidx < 128) { const f32x4* kr = (const f32x4*)(F.in[2] + ((size_t)b * 128 + kidx) * 256 + g * 64);
#pragma unroll 8
            for (int d4 = 0; d4 < 16; ++d4) { const f32x4 kv = kr[d4];
#pragma unroll
                for (int t = 0; t < 4; ++t) { const f32x4 q = *(const LAS f32x4*)(sq + t * 64 + d4 * 4); sc[kk][t] += kv[0] * q[0] + kv[1] * q[1] + kv[2] * q[2] + kv[3] * q[3]; } } }
        else if (kidx < 132) { const int tn = kidx - 128;
#pragma unroll 4
            for (int d = 0; d < 64; ++d) { const float kv = sk[tn * 64 + d];
#pragma unroll
                for (int t = 0; t < 4; ++t) sc[kk][t] += kv * sq[t * 64 + d]; } }
#pragma unroll
        for (int t = 0; t < 4; ++t) { const bool ok = (kidx < 132) && (kidx > t) && (kidx <= t + 128); if (!ok) sc[kk][t] = -INFINITY; } }
    float linv[4];
#pragma unroll
    for (int t = 0; t < 4; ++t) { float m = fmaxf(fmaxf(sc[0][t], sc[1][t]), sc[2][t]); m = fmaxf(wave_max(m), sink);
        float sum = 0.f;
#pragma unroll
        for (int kk = 0; kk < 3; ++kk) { const float p = __expf(sc[kk][t] - m); sum += p; const int kidx = kk * 64 + lane; if (kidx < 160) sp[t * 160 + kidx] = p; }
        sum = wave_sum(sum) + __expf(sink - m); linv[t] = 1.f / sum; }
    const int kq = lane >> 4, dq = lane & 15;
    f32x4 o[4];
#pragma unroll
    for (int t = 0; t < 4; ++t) o[t] = (f32x4){0.f, 0.f, 0.f, 0.f};
    const float* vb = F.in[3] + ((size_t)b * 128 + kq) * 256 + g * 64 + dq * 4;
#pragma unroll 8
    for (int kb = 0; kb < 32; ++kb) { const f32x4 vv = *(const f32x4*)(vb + (size_t)kb * 1024);
#pragma unroll
        for (int t = 0; t < 4; ++t) o[t] += vv * sp[t * 160 + kb * 4 + kq]; }
    { const f32x4 vv = *(const LAS f32x4*)(sv + kq * 64 + dq * 4);
#pragma unroll
      for (int t = 0; t < 4; ++t) o[t] += vv * sp[t * 160 + 128 + kq]; }
#pragma unroll
    for (int t = 0; t < 4; ++t) {
#pragma unroll
        for (int e = 0; e < 4; ++e) { float v = o[t][e]; v += __shfl_xor(v, 16); v += __shfl_xor(v, 32); o[t][e] = v * linv[t]; }
        if (kq == t) { u32x2 pk; pk.x = cvt_pk_bf16(o[t][0], o[t][1]); pk.y = cvt_pk_bf16(o[t][2], o[t][3]); *(u32x2*)(MIX + (size_t)(SP + b * 4 + t) * D + hq * 64 + dq * 4) = pk; } }
}

__device__ __forceinline__ void mlstm_sample_unit(const Frame& F, int b, int h) {
    const bf16_t* P = (const bf16_t*)(F.ws + WS_P); const float* gates = (const float*)(F.ws + WS_GATES);
    bf16_t* MIX = (bf16_t*)(F.ws + WS_MIX);
    LAS float* sq = (LAS float*)F.lds; LAS float* sk = sq + 1024; LAS float* sv = sk + 1024; LAS float* sS = sv + 1024;
    const int tid = F.tid, lane = F.lane;
    const int bh = b * 4 + h;
    for (int i = tid; i < 1024; i += 512) { const int t = i >> 8, d = i & 255; const bf16_t* row = P + (size_t)(SP + b * 4 + t) * NIN;
        sq[i] = bf2f(row[C_MQ + h * 256 + d]) * 0.0625f; sk[i] = bf2f(row[C_MK + h * 256 + d]); sv[i] = bf2f(row[C_MV + h * 256 + d]); }
    if (tid < 64) sS[tid] = 0.f;
    __syncthreads();
    {
        const int pair = tid >> 5, sub = tid & 31, t = pair >> 2, s = pair & 3; float a = 0.f, c = 0.f;
#pragma unroll
        for (int e = 0; e < 8; ++e) { const int d = sub * 8 + e; a += sq[t * 256 + d] * sk[s * 256 + d]; if (s == 0) c += sq[t * 256 + d] * F.in[5][(size_t)bh * 256 + d]; }
#pragma unroll
        for (int o = 16; o >= 1; o >>= 1) { a += __shfl_xor(a, o); c += __shfl_xor(c, o); }
        if (sub == 0) { sS[pair] = a; if (s == 0) sS[16 + t] = c; } }
    __syncthreads();
    float li[4], bcum[4], mt[4], at[4], gs[4], sm[4][4], den[4];
    const float m0 = F.in[6][bh];
    { float acc = 0.f;
#pragma unroll
      for (int t = 0; t < 4; ++t) { const float* gp = gates + (size_t)(SP + b * 4 + t) * 8; li[t] = gp[h] + F.in[15][h]; acc += logsigmoid_fast(gp[4 + h] + F.in[16][h]); bcum[t] = acc; } }
#pragma unroll
    for (int t = 0; t < 4; ++t) { const float mi = bcum[t] + m0; float m = mi;
#pragma unroll
        for (int s = 0; s < 4; ++s) if (s <= t) m = fmaxf(m, bcum[t] - bcum[s] + li[s]);
        mt[t] = m; at[t] = __expf(mi - m); float dsum = at[t] * sS[16 + t];
#pragma unroll
        for (int s = 0; s < 4; ++s) { sm[t][s] = (s <= t) ? sS[t * 4 + s] * __expf(bcum[t] - bcum[s] + li[s] - m) : 0.f; dsum += sm[t][s]; }
        den[t] = fmaxf(fabsf(dsum), __expf(-m)); }
    const float mnew = mt[3], decay = __expf(bcum[3] + m0 - mnew);
#pragma unroll
    for (int s = 0; s < 4; ++s) gs[s] = __expf(bcum[3] - bcum[s] + li[s] - mnew);
    const int r8 = lane >> 3, seg = lane & 7, w = F.wave;
    const float* c0b = F.in[4] + (size_t)bh * 65536 + (size_t)(w * 32 + r8) * 256 + seg * 4;
    float* c1b = F.out + O_CS + (size_t)bh * 65536 + (size_t)(w * 32 + r8) * 256 + seg * 4;
    float acc[4][4], gv[4][4];
#pragma unroll
    for (int rg = 0; rg < 4; ++rg)
#pragma unroll
        for (int t = 0; t < 4; ++t) { acc[rg][t] = 0.f; gv[rg][t] = gs[t] * sv[t * 256 + w * 32 + rg * 8 + r8]; }
    if (tid == 0) {
#pragma unroll
        for (int t = 0; t < 4; ++t) { sS[40 + t] = at[t]; sS[44 + t] = den[t];
#pragma unroll
            for (int s2 = 0; s2 < 4; ++s2) sS[48 + t * 4 + s2] = sm[t][s2]; } }
    f32x4 c[2][2][4];
#pragma unroll
    for (int i2 = 0; i2 < 2; ++i2)
#pragma unroll
        for (int rg = 0; rg < 4; ++rg) c[0][i2][rg] = __builtin_nontemporal_load((const f32x4*)(c0b + rg * 2048 + i2 * 32));
#pragma unroll
    for (int hh = 0; hh < 4; ++hh) {
        if (hh < 3) {
#pragma unroll
            for (int i2 = 0; i2 < 2; ++i2)
#pragma unroll
                for (int rg = 0; rg < 4; ++rg) c[(hh + 1) & 1][i2][rg] = __builtin_nontemporal_load((const f32x4*)(c0b + rg * 2048 + ((hh + 1) * 2 + i2) * 32)); }
#pragma unroll
        for (int i2 = 0; i2 < 2; ++i2) { const int it = hh * 2 + i2; const int d = it * 32 + seg * 4;
            f32x4 q[4], k[4];
#pragma unroll
            for (int t = 0; t < 4; ++t) { q[t] = *(const LAS f32x4*)(sq + t * 256 + d); k[t] = *(const LAS f32x4*)(sk + t * 256 + d); }
#pragma unroll
            for (int rg = 0; rg < 4; ++rg) { const f32x4 cv = c[hh & 1][i2][rg]; f32x4 nv = cv * decay;
#pragma unroll
                for (int t = 0; t < 4; ++t) { acc[rg][t] += cv[0] * q[t][0] + cv[1] * q[t][1] + cv[2] * q[t][2] + cv[3] * q[t][3]; nv += k[t] * gv[rg][t]; }
                __builtin_nontemporal_store(nv, (f32x4*)(c1b + rg * 2048 + it * 32)); } }
    }
    __syncthreads();
    float hv[4][4], ssq[4] = {0.f, 0.f, 0.f, 0.f};
#pragma unroll
    for (int rg = 0; rg < 4; ++rg)
#pragma unroll
        for (int t = 0; t < 4; ++t) { float a = acc[rg][t]; a += __shfl_xor(a, 1); a += __shfl_xor(a, 2); a += __shfl_xor(a, 4);
            float num = sS[40 + t] * a;
#pragma unroll
            for (int s2 = 0; s2 < 4; ++s2) num += sS[48 + t * 4 + s2] * sv[s2 * 256 + w * 32 + rg * 8 + r8];
            hv[rg][t] = num / sS[44 + t]; if (seg == 0) ssq[t] += hv[rg][t] * hv[rg][t]; }
#pragma unroll
    for (int t = 0; t < 4; ++t) { ssq[t] = wave_sum(ssq[t]); }
    if (lane == 0) {
#pragma unroll
        for (int t = 0; t < 4; ++t) lds_add(&sS[32 + t], ssq[t]); }
    if (tid < 256) { float nn = decay * F.in[5][(size_t)bh * 256 + tid];
#pragma unroll
        for (int s2 = 0; s2 < 4; ++s2) nn += gs[s2] * sk[s2 * 256 + tid];
        F.out[O_NS + (size_t)bh * 256 + tid] = nn; }
    if (tid == 0) F.out[O_MS + bh] = mnew;
    __syncthreads();
#pragma unroll
    for (int rg = 0; rg < 4; ++rg)
#pragma unroll
        for (int t = 0; t < 4; ++t) if (seg == ((rg * 4 + t) & 7)) { const int vr = w * 32 + rg * 8 + r8; const size_t row = (size_t)(SP + b * 4 + t);
            const float rms = rsqrtf(sS[32 + t] * (1.f / 256.f) + EPS); const float og = sigmoidf_(bf2f(P[row * NIN + C_MO + h * 256 + vr]));
            MIX[row * D + 1024 + h * 256 + vr] = (bf16_t)(cvt_pk_bf16(hv[rg][t] * rms * F.in[18][h * 256 + vr] * og, 0.f) & 0xffff); }
    __syncthreads();
}

__device__ __forceinline__ void mlstm_u_unit(const Frame& F, int c, int h, int vh) {
    const bf16_t* P = (const bf16_t*)(F.ws + WS_P);
    const float* BW = (const float*)(F.ws + WS_BW) + h * SP; const float* MR = (const float*)(F.ws + WS_MR) + h * SP;
    LAS bf16_t* VtS = (LAS bf16_t*)F.lds;
    LAS bf16_t* KtS = VtS + 128 * 72;
    LAS float* gS = (LAS float*)(KtS + 256 * 72);
    const int lane = F.lane, fr = lane & 15, kg = lane >> 4, w = F.wave;
    const float mend = MR[c * LC + LC - 1];
    f32x4 acc[4][4];
#pragma unroll
    for (int a = 0; a < 4; ++a)
#pragma unroll
        for (int b = 0; b < 4; ++b) acc[a][b] = (f32x4){0.f, 0.f, 0.f, 0.f};
    float un = 0.f;
    u32x4 vr0, vr1, kr[2][2]; float bw0, bw1, bwg;
#define D1_LOAD(sbx) do { const int s0x = c * LC + (sbx) * 64; { const int s2 = F.tid & 31, vg = F.tid >> 5; bw0 = BW[s0x + 2 * s2]; bw1 = BW[s0x + 2 * s2 + 1]; bwg = BW[s0x + (F.tid & 63)]; \
            const bf16_t* src = P + (size_t)(s0x + 2 * s2) * NIN + C_MV + h * 256 + vh * 128 + vg * 8; vr0 = *(const u32x4*)src; vr1 = *(const u32x4*)(src + NIN); } \
        _Pragma("unroll") for (int it = 0; it < 2; ++it) { const int item = it * 512 + F.tid, s2 = item & 31, dg = item >> 5; const bf16_t* src = P + (size_t)(s0x + 2 * s2) * NIN + C_MK + h * 256 + dg * 8; \
            kr[it][0] = *(const u32x4*)src; kr[it][1] = *(const u32x4*)(src + NIN); } } while (0)
    D1_LOAD(0);
    for (int sb = 0; sb < LC / 64; ++sb) {
        if (F.tid < 64) gS[F.tid] = __expf(bwg - mend);
        { const int s2 = F.tid & 31, vg = F.tid >> 5; const float g0 = __expf(bw0 - mend), g1 = __expf(bw1 - mend);
            float f0[8], f1[8]; unpack8(vr0, f0); unpack8(vr1, f1);
#pragma unroll
            for (int i = 0; i < 8; ++i) *(LAS unsigned*)(VtS + (vg * 8 + i) * 72 + 2 * s2) = cvt_pk_bf16(f0[i] * g0, f1[i] * g1); }
#pragma unroll
        for (int it = 0; it < 2; ++it) { const int item = it * 512 + F.tid, s2 = item & 31, dg = item >> 5;
            unsigned wd[8]; zip8(kr[it][0], kr[it][1], wd);
#pragma unroll
            for (int i = 0; i < 8; ++i) *(LAS unsigned*)(KtS + (dg * 8 + i) * 72 + 2 * s2) = wd[i]; }
        if (sb + 1 < LC / 64) D1_LOAD(sb + 1);
        __syncthreads();
#pragma unroll
        for (int ks = 0; ks < 2; ++ks) { bf16x8 vf[4];
#pragma unroll
            for (int vt = 0; vt < 4; ++vt) vf[vt] = *(const LAS bf16x8*)(VtS + ((w & 1) * 64 + vt * 16 + fr) * 72 + ks * 32 + kg * 8);
#pragma unroll
            for (int dt = 0; dt < 4; ++dt) { const bf16x8 kf = *(const LAS bf16x8*)(KtS + ((w >> 1) * 64 + dt * 16 + fr) * 72 + ks * 32 + kg * 8);
#pragma unroll
                for (int vt = 0; vt < 4; ++vt) acc[dt][vt] = __builtin_amdgcn_mfma_f32_16x16x32_bf16(kf, vf[vt], acc[dt][vt], 0, 0, 0); } }
        if (vh == 0 && F.tid < 256) {
#pragma unroll
            for (int j8 = 0; j8 < 8; ++j8) { float kf[8]; unpack8(*(const LAS u32x4*)(KtS + F.tid * 72 + j8 * 8), kf); const f32x4 ga = *(const LAS f32x4*)(gS + j8 * 8), gb = *(const LAS f32x4*)(gS + j8 * 8 + 4);
                un += ga[0] * kf[0] + ga[1] * kf[1] + ga[2] * kf[2] + ga[3] * kf[3] + gb[0] * kf[4] + gb[1] * kf[5] + gb[2] * kf[6] + gb[3] * kf[7]; } }
        __syncthreads(); }
    float* U = (float*)(F.ws + WS_U) + ((size_t)(c * 4 + h) * 256) * 256;
#pragma unroll
    for (int dt = 0; dt < 4; ++dt)
#pragma unroll
        for (int vt = 0; vt < 4; ++vt) { const int v = vh * 128 + (w & 1) * 64 + vt * 16 + fr, d = (w >> 1) * 64 + dt * 16 + kg * 4; *(f32x4*)(U + (size_t)v * 256 + d) = acc[dt][vt]; }
    if (vh == 0 && F.tid < 256) ((float*)(F.ws + WS_UN))[(c * 4 + h) * 256 + F.tid] = un;
}

#undef D1_LOAD
__device__ __forceinline__ void mlstm_state_scan(const Frame& F) {
    const float* MRb = (const float*)(F.ws + WS_MR);
    const float* U = (const float*)(F.ws + WS_U); bf16_t* CST = (bf16_t*)(F.ws + WS_CST);
    LAS float* sdec = (LAS float*)F.lds;
    if (F.tid < 128) { const int h = F.tid >> 5, c = F.tid & 31; const float* MR = MRb + h * SP; sdec[F.tid] = expf((c == 0 ? 0.f : MR[c * LC - 1]) - MR[c * LC + LC - 1]); }
    __syncthreads();
    const int gt = F.bid * 512 + F.tid, GT = F.G * 512;
    typedef float f32x2 __attribute__((ext_vector_type(2)));
    for (int e2 = gt; e2 < 131072; e2 += GT) { const int h = e2 >> 15;
        f32x2 C = (f32x2){0.f, 0.f};
#pragma unroll 1
        for (int c0 = 0; c0 < NCH; c0 += 8) { f32x2 u[8];
#pragma unroll
            for (int k = 0; k < 8; ++k) u[k] = *(const f32x2*)(U + (size_t)(c0 + k) * 262144 + (size_t)e2 * 2);
#pragma unroll
            for (int k = 0; k < 8; ++k) { *(unsigned*)(CST + (size_t)(c0 + k) * 262144 + (size_t)e2 * 2) = cvt_pk_bf16(C[0], C[1]); C = C * sdec[h * 32 + c0 + k] + u[k]; } }
        *(f32x2*)(F.out + O_CP + (size_t)e2 * 2) = C; }
    for (int e = gt; e < 1024; e += GT) { const int h = e >> 8; const float* UN = (const float*)(F.ws + WS_UN); float* NST = (float*)(F.ws + WS_NST);
        float n = 0.f;
        for (int c = 0; c < NCH; ++c) { NST[c * 1024 + e] = n; n = n * sdec[h * 32 + c] + UN[c * 1024 + e]; }
        F.out[O_NP + e] = n; }
    __syncthreads();
}

__device__ __forceinline__ void mlstm_out_unit(const Frame& F, int c, int h, int tb) {
    const bf16_t* P = (const bf16_t*)(F.ws + WS_P); bf16_t* MIX = (bf16_t*)(F.ws + WS_MIX);
    const float* BC = (const float*)(F.ws + WS_BC) + h * SP; const float* BW = (const float*)(F.ws + WS_BW) + h * SP; const float* MR = (const float*)(F.ws + WS_MR) + h * SP;
    const bf16_t* CST = (const bf16_t*)(F.ws + WS_CST) + (size_t)(c * 4 + h) * 65536; const float* NST = (const float*)(F.ws + WS_NST) + (c * 4 + h) * 256;
    LAS bf16_t* Qs = (LAS bf16_t*)F.lds;
    LAS bf16_t* Ks = Qs + 64 * 264;
    LAS bf16_t* VtS = Ks + 64 * 264;
    LAS bf16_t* Ps = VtS + 256 * 72;
    LAS float* sA = (LAS float*)(Ps + 64 * 72);
    LAS float* sDen = sA + 64;
    LAS float* sMr = sDen + 64;
    LAS float* sSq = sMr + 64;
    const int tid = F.tid, lane = F.lane, fr = lane & 15, kg = lane >> 4, w = F.wave;
    const int t0 = c * LC + tb * 64;
    const float mstart = c == 0 ? 0.f : MR[c * LC - 1];
#pragma unroll
    for (int it = 0; it < 4; ++it) { const int item = it * 512 + tid, t = item >> 5, dg = item & 31;
        *(LAS u32x4*)(Qs + t * 264 + dg * 8) = *(const u32x4*)(P + (size_t)(t0 + t) * NIN + C_MQ + h * 256 + dg * 8); }
    u32x4 kreg[4], vreg[2][2];
#define P6_LOAD(sbx) do { const int s0x = c * LC + (sbx) * 64; _Pragma("unroll") for (int it = 0; it < 4; ++it) { const int item = it * 512 + tid, sx = item >> 5, dg = item & 31; \
            kreg[it] = *(const u32x4*)(P + (size_t)(s0x + sx) * NIN + C_MK + h * 256 + dg * 8); } \
        _Pragma("unroll") for (int it = 0; it < 2; ++it) { const int item = it * 512 + tid, s2 = item & 31, vg = item >> 5; const bf16_t* src = P + (size_t)(s0x + 2 * s2) * NIN + C_MV + h * 256 + vg * 8; \
            vreg[it][0] = *(const u32x4*)src; vreg[it][1] = *(const u32x4*)(src + NIN); } } while (0)
    P6_LOAD(0);
    if (tid < 64) { const float mr = MR[t0 + tid]; sMr[tid] = mr; sA[tid] = expf(mstart - mr) * 0.0625f; sSq[tid] = 0.f; }
    __syncthreads();
    {
        const int t = tid >> 3, sub = tid & 7; float a = 0.f; f32x4 nv[8];
#pragma unroll
        for (int e4 = 0; e4 < 8; ++e4) nv[e4] = *(const f32x4*)(NST + sub * 32 + e4 * 4);
#pragma unroll
        for (int e4 = 0; e4 < 8; ++e4) { const u32x2 qq = *(const LAS u32x2*)(Qs + t * 264 + sub * 32 + e4 * 4);
            a += bf_lo(qq.x) * nv[e4][0] + bf_hi(qq.x) * nv[e4][1] + bf_lo(qq.y) * nv[e4][2] + bf_hi(qq.y) * nv[e4][3]; }
        a += __shfl_xor(a, 1); a += __shfl_xor(a, 2); a += __shfl_xor(a, 4);
        if (sub == 0) sDen[t] = a * sA[t]; }
    f32x4 acc[4][2];
#pragma unroll
    for (int a = 0; a < 4; ++a) { acc[a][0] = (f32x4){0.f, 0.f, 0.f, 0.f}; acc[a][1] = acc[a][0]; }
    { bf16x8 cf[8][2];
#pragma unroll
      for (int ks = 0; ks < 8; ++ks)
#pragma unroll
          for (int vt = 0; vt < 2; ++vt) cf[ks][vt] = __builtin_bit_cast(bf16x8, *(const u32x4*)(CST + (size_t)(w * 32 + vt * 16 + fr) * 256 + ks * 32 + kg * 8));
#pragma unroll
      for (int ks = 0; ks < 8; ++ks)
#pragma unroll
          for (int tt = 0; tt < 4; ++tt) { const bf16x8 qf = *(const LAS bf16x8*)(Qs + (tt * 16 + fr) * 264 + ks * 32 + kg * 8);
#pragma unroll
              for (int vt = 0; vt < 2; ++vt) acc[tt][vt] = __builtin_amdgcn_mfma_f32_16x16x32_bf16(qf, cf[ks][vt], acc[tt][vt], 0, 0, 0); } }
#pragma unroll
    for (int tt = 0; tt < 4; ++tt)
#pragma unroll
        for (int j = 0; j < 4; ++j) { const float a = sA[tt * 16 + kg * 4 + j]; acc[tt][0][j] *= a; acc[tt][1][j] *= a; }
    __syncthreads();
    for (int sb = 0; sb <= tb; ++sb) { const int s0 = c * LC + sb * 64;
#pragma unroll
        for (int it = 0; it < 4; ++it) { const int item = it * 512 + tid, sx = item >> 5, dg = item & 31; *(LAS u32x4*)(Ks + sx * 264 + dg * 8) = kreg[it]; }
#pragma unroll
        for (int it = 0; it < 2; ++it) { const int item = it * 512 + tid, s2 = item & 31, vg = item >> 5;
            unsigned wd[8]; zip8(vreg[it][0], vreg[it][1], wd);
#pragma unroll
            for (int i = 0; i < 8; ++i) *(LAS unsigned*)(VtS + (vg * 8 + i) * 72 + 2 * s2) = wd[i]; }
        if (sb < tb) P6_LOAD(sb + 1);
        __syncthreads();
        {
            const int tt = w >> 1; f32x4 sacc[2]; sacc[0] = (f32x4){0.f, 0.f, 0.f, 0.f}; sacc[1] = sacc[0];
#pragma unroll 2
            for (int ks = 0; ks < 8; ++ks) { const bf16x8 qf = *(const LAS bf16x8*)(Qs + (tt * 16 + fr) * 264 + ks * 32 + kg * 8);
#pragma unroll
                for (int x = 0; x < 2; ++x) { const bf16x8 kf = *(const LAS bf16x8*)(Ks + (((w & 1) * 2 + x) * 16 + fr) * 264 + ks * 32 + kg * 8);
                    sacc[x] = __builtin_amdgcn_mfma_f32_16x16x32_bf16(qf, kf, sacc[x], 0, 0, 0); } }
            float rs[4] = {0.f, 0.f, 0.f, 0.f};
#pragma unroll
            for (int x = 0; x < 2; ++x) { const int sl = ((w & 1) * 2 + x) * 16 + fr; const float ws = BW[s0 + sl];
#pragma unroll
                for (int j = 0; j < 4; ++j) { const int tl = tt * 16 + kg * 4 + j; const bool ok = (s0 + sl) <= (t0 + tl);
                    const float pv = ok ? sacc[x][j] * 0.0625f * expf(ws - sMr[tl]) : 0.f; rs[j] += pv;
                    Ps[tl * 72 + sl] = (bf16_t)(cvt_pk_bf16(pv, 0.f) & 0xffff); } }
#pragma unroll
            for (int j = 0; j < 4; ++j) { float r = rs[j]; r += __shfl_xor(r, 1); r += __shfl_xor(r, 2); r += __shfl_xor(r, 4); r += __shfl_xor(r, 8);
                if (fr == 0) lds_add(&sDen[tt * 16 + kg * 4 + j], r); } }
        __syncthreads();
#pragma unroll
        for (int ks = 0; ks < 2; ++ks) { bf16x8 vf[2];
#pragma unroll
            for (int vt = 0; vt < 2; ++vt) vf[vt] = *(const LAS bf16x8*)(VtS + (w * 32 + vt * 16 + fr) * 72 + ks * 32 + kg * 8);
#pragma unroll
            for (int tt = 0; tt < 4; ++tt) { const bf16x8 pf = *(const LAS bf16x8*)(Ps + (tt * 16 + fr) * 72 + ks * 32 + kg * 8);
#pragma unroll
                for (int vt = 0; vt < 2; ++vt) acc[tt][vt] = __builtin_amdgcn_mfma_f32_16x16x32_bf16(pf, vf[vt], acc[tt][vt], 0, 0, 0); } }
        __syncthreads(); }
#pragma unroll
    for (int tt = 0; tt < 4; ++tt)
#pragma unroll
        for (int j = 0; j < 4; ++j) { const int tl = tt * 16 + kg * 4 + j; const float mt = BC[t0 + tl] + sMr[tl]; const float dn = 1.f / fmaxf(fabsf(sDen[tl]), expf(-mt));
            acc[tt][0][j] *= dn; acc[tt][1][j] *= dn; float q = acc[tt][0][j] * acc[tt][0][j] + acc[tt][1][j] * acc[tt][1][j];
            q += __shfl_xor(q, 1); q += __shfl_xor(q, 2); q += __shfl_xor(q, 4); q += __shfl_xor(q, 8);
            if (fr == 0) lds_add(&sSq[tl], q); }
    __syncthreads();
    {
        float ogp[4][4][2]; const float nw0 = F.in[18][h * 256 + w * 32 + fr], nw1 = F.in[18][h * 256 + w * 32 + 16 + fr];
#pragma unroll
        for (int tt = 0; tt < 4; ++tt)
#pragma unroll
            for (int j = 0; j < 4; ++j) { const size_t row = (size_t)(t0 + tt * 16 + kg * 4 + j);
#pragma unroll
                for (int vt = 0; vt < 2; ++vt) ogp[tt][j][vt] = bf2f(P[row * NIN + C_MO + h * 256 + w * 32 + vt * 16 + fr]); }
#pragma unroll
        for (int tt = 0; tt < 4; ++tt)
#pragma unroll
            for (int j = 0; j < 4; ++j) { const int tl = tt * 16 + kg * 4 + j; const float rms = rsqrtf(sSq[tl] * (1.f / 256.f) + EPS); const size_t row = (size_t)(t0 + tl);
#pragma unroll
                for (int vt = 0; vt < 2; ++vt) { const int v = w * 32 + vt * 16 + fr;
                    MIX[row * D + 1024 + h * 256 + v] = (bf16_t)(cvt_pk_bf16(acc[tt][vt][j] * rms * (vt == 0 ? nw0 : nw1) * sigmoidf_(ogp[tt][j][vt]), 0.f) & 0xffff); } } }
    __syncthreads();
}

#undef P6_LOAD
__device__ __forceinline__ void final_norm_phase(const Frame& F, int rlo) {
    const float* nw = F.in[11];
    for (int r = rlo + F.bid * 8 + F.wave; r < MTOT; r += F.G * 8) { f32x4* xr = (f32x4*)(F.out + (size_t)r * D);
        const f32x4* sr = r < SP ? xr : (const f32x4*)(F.ws + WS_X1) + (size_t)r * (D / 4);
        f32x4 xv[8]; float ss = 0.f;
#pragma unroll
        for (int i = 0; i < 8; ++i) xv[i] = sr[i * 64 + F.lane];
        if (r >= SP) { for (int z = 0; z < 11; ++z) { const f32x4* pp = (const f32x4*)(F.ws + WS_PART) + ((size_t)z * MS + (r - SP)) * (D / 4);
#pragma unroll
                for (int i = 0; i < 8; ++i) xv[i] += pp[i * 64 + F.lane]; } }
#pragma unroll
        for (int i = 0; i < 8; ++i) ss += xv[i][0] * xv[i][0] + xv[i][1] * xv[i][1] + xv[i][2] * xv[i][2] + xv[i][3] * xv[i][3];
        ss = wave_sum(ss); const float rstd = rsqrtf(ss * (1.f / D) + EPS);
#pragma unroll
        for (int i = 0; i < 8; ++i) { const f32x4 w = ((const f32x4*)nw)[i * 64 + F.lane]; xr[i * 64 + F.lane] = xv[i] * rstd * w; } }
}

__global__ void __launch_bounds__(512, 2) fwd_mega(Params prm) {
    extern __shared__ __attribute__((aligned(16))) unsigned char lds_raw[];
    cg::grid_group grid = cg::this_grid();
    Frame F;
    F.lds = (LAS unsigned char*)lds_raw; F.tid = threadIdx.x; F.lane = F.tid & 63; F.wave = __builtin_amdgcn_readfirstlane(F.tid >> 6); F.G = gridDim.x; F.bid = blockIdx.x;
#pragma unroll
    for (int i = 0; i < 23; ++i) F.in[i] = prm.in[i];
    F.out = prm.out; F.ws = prm.ws;
    unsigned char* ws = F.ws;
    const int lo = prm.ph_lo, hi = prm.ph_hi;
#ifndef PH_MASK
#define PH_MASK 0xfff
#endif
#define IN(k) (((PH_MASK >> (k)) & 1) && lo <= (k) && (k) < hi)
#define SEAM(k) do { if (IN(k) && IN((k) + 1)) { if ((k) == 0) grid.sync(); else xcd_barrier(xbar); } } while (0)
#ifndef REPMASK
#define REPMASK 0
#endif
#define REPS(k) for (int rep_ = 0; rep_ < 1 + ((REPMASK >> (k)) & 1); ++rep_, (((REPMASK >> (k)) & 1) && rep_ == 1 ? grid.sync() : (void)0))
    const float* mod = (const float*)(ws + WS_MOD);
    volatile LAS unsigned* xst = (volatile LAS unsigned*)(F.lds + LDS_BYTES - 16);
    if (F.tid == 0) { xst[0] = 0u; xst[1] = 0u; }
    __syncthreads();
    XcdBarrier xbar; xbar.bar = (unsigned*)(ws + WS_BAR); xbar.x = 0; xbar.st = xst;
    if (hi - lo > 1) xbar = xcd_barrier_post((unsigned*)(ws + WS_BAR), xst);

    if (IN(0)) REPS(0) p0_prologue(F);
    SEAM(0);
    if (IN(1)) { { const int cb = F.G > 96 ? 48 : 0;
          if (F.bid >= cb) convert_tiles(F, 2496, 4608, F.bid - cb, F.G - cb); }
        pg8::Gemm g{(const bf16_t*)(ws + WS_SILU), (const bf16_t*)(ws + WS_WADA), D, D}; pg8::SplitKOrder S{48, 1, F.G, F.bid, 32};
        pg8::EpiMod E{(float*)(ws + WS_MOD), F.in[13]}; pg8::gemm_phase(F.lds, g, S, E); }
    SEAM(1);
    if (IN(2)) REPS(2) norm_mod_phase<true>(F, F.in[0], F.in[1], F.in[9], 0, 2048, 0, nullptr);
    SEAM(2);
    if (IN(3)) REPS(3) {
        if (F.bid >= F.G - 4) mlstm_scan(F, F.bid - (F.G - 4));
        pg8::Gemm g{(const bf16_t*)(ws + WS_H), (const bf16_t*)(ws + WS_WIN), D, D}; pg8::StaticOrder S; S.init(MTOT, NIN, F.G, F.bid, D / 64);
        pg8::EpiBf16 E{(bf16_t*)(ws + WS_P), NIN}; pg8::gemm_phase(F.lds, g, S, E); }
    SEAM(3);
    if (IN(4)) REPS(4) {
        const bool cfirst = (F.bid & 1) != 0;
        if (cfirst && (prm.p4m & 2)) for (int u = F.bid; u < 512; u += F.G) mlstm_sample_unit(F, u >> 2, u & 3);
        if (prm.p4m & 1) for (int u = F.bid; u < 256; u += F.G) mlstm_u_unit(F, u >> 3, (u >> 1) & 3, u & 1);
        if (prm.p4m & 4) for (int u = F.bid; u < 512; u += F.G) attn_prompt_unit(F, u >> 2, u & 3);
        if (prm.p4m & 8) for (int rep = 0; rep < ((prm.p4m & 16) ? 2 : 1); ++rep) for (int u = F.bid * 8 + F.wave; u < 2048; u += F.G * 8) attn_sample_wave(F, u);
        if (!cfirst && (prm.p4m & 2)) for (int u = F.bid; u < 512; u += F.G) mlstm_sample_unit(F, u >> 2, u & 3);
        { const bf16_t* P = (const bf16_t*)(ws + WS_P); const float* rope = (const float*)(ws + WS_ROPE);
          for (int i = F.bid * 512 + F.tid; i < 32768; i += F.G * 512) { const int pos = SP - 128 + (i >> 8), cc = i & 255, d = cc & 63; const bf16_t* row = P + (size_t)pos * NIN;
              float kv = bf2f(row[C_AK + cc]);
              if (d < 16) { const float ko = bf2f(row[C_AK + (cc ^ 8)]); const float cs = rope[pos * 16 + (d & 7)], sn = rope[pos * 16 + 8 + (d & 7)]; kv = d < 8 ? kv * cs - ko * sn : kv * cs + ko * sn; }
              F.out[O_KWP + i] = kv; F.out[O_VWP + i] = bf2f(row[C_AV + cc]); } }
    }
    SEAM(4);
    if (IN(5)) REPS(5) mlstm_state_scan(F);
    SEAM(5);
    if (IN(6)) REPS(6) { for (int u = F.bid; u < 512; u += F.G) { const int tb = u < 256 ? 3 - (u >> 7) : ((u - 256) >> 7); const int ch = u & 127; mlstm_out_unit(F, ch >> 2, ch & 3, tb); } }
    SEAM(6);
    if (IN(7)) REPS(7) { pg8::Gemm g{(const bf16_t*)(ws + WS_MIX), (const bf16_t*)(ws + WS_WOUT), D, D}; pg8::PromptSampleOrder S{F.G, F.bid, D / 64, 4};
        pg8::EpiRes E{(float*)(ws + WS_X1), F.in[0], F.in[1], mod + 4096, (float*)(ws + WS_PART)}; pg8::gemm_phase(F.lds, g, S, E);
        if (F.G == 256) { if (F.bid >= 64) kvwin_copy(F, (F.bid - 64) * 512 + F.tid, (F.G - 64) * 512); } else kvwin_copy(F, F.bid * 512 + F.tid, F.G * 512); }
    SEAM(7);
    if (IN(8)) REPS(8) { float* x1 = (float*)(ws + WS_X1); norm_mod_phase<false>(F, x1, F.in[1], F.in[10], 3 * 2048, 4 * 2048, 4, x1 + (size_t)SP * D); }
    SEAM(8);
    if (IN(9)) REPS(9) { pg8::Gemm g{(const bf16_t*)(ws + WS_H), (const bf16_t*)(ws + WS_WGU), D, D}; pg8::StaticOrder S; S.init(MTOT, 2 * DFF, F.G, F.bid, D / 64);
        pg8::EpiGU E{(bf16_t*)(ws + WS_P), DFF}; pg8::gemm_phase(F.lds, g, S, E); }
    SEAM(9);
    if (IN(10)) REPS(10) { const float* x1 = (const float*)(ws + WS_X1); pg8::Gemm g{(const bf16_t*)(ws + WS_P), (const bf16_t*)(ws + WS_WDN), DFF, DFF}; pg8::PromptSampleOrder S{F.G, F.bid, DFF / 64, 11};
        if (F.G == 256) { pg8::EpiResNorm E{F.out + O_Y, x1, mod + 5 * 2048, (float*)(ws + WS_PART), F.in[11], (float*)(ws + WS_SSQ), (unsigned*)(ws + WS_PCNT), (LAS float*)(F.lds + 131072)}; pg8::gemm_phase(F.lds, g, S, E); }
        else { pg8::EpiRes E{F.out + O_Y, x1, x1 + (size_t)SP * D, mod + 5 * 2048, (float*)(ws + WS_PART)}; pg8::gemm_phase(F.lds, g, S, E); } }
    SEAM(10);
    if (IN(11)) final_norm_phase(F, F.G == 256 ? SP : 0);
#undef IN
#undef SEAM
}

#ifndef MK_MULTI
#define MK_MULTI 0
#endif

extern "C" void kernel_launch(void* const* d_in, const int* in_sizes, int n_in, void* d_out, int out_size, void* d_ws, size_t ws_size, hipStream_t stream) {
    static int grid = 0;
    if (grid == 0) {
        if (n_in != 23 || (size_t)out_size != O_END || ws_size < WS_END) { fprintf(stderr, "kernel_launch: unexpected sizes: n_in %d out %d (want %zu) ws %zu (want >= %zu)\n", n_in, out_size, (size_t)O_END, ws_size, (size_t)WS_END); grid = -1; return; }
        int dev = 0, cus = 0, per_cu = 0;
        (void)hipGetDevice(&dev); (void)hipDeviceGetAttribute(&cus, hipDeviceAttributeMultiprocessorCount, dev);
        if (hipFuncSetAttribute((const void*)fwd_mega, hipFuncAttributeMaxDynamicSharedMemorySize, LDS_BYTES) != hipSuccess) { fprintf(stderr, "kernel_launch: hipFuncSetAttribute failed\n"); grid = -1; return; }
        if (hipOccupancyMaxActiveBlocksPerMultiprocessor(&per_cu, (const void*)fwd_mega, 512, LDS_BYTES) != hipSuccess || per_cu < 1) { fprintf(stderr, "kernel_launch: occupancy query says %d blocks/CU\n", per_cu); per_cu = 1; }
        (void)hipGetLastError();
        grid = cus * 1;
        fprintf(stderr, "kernel_launch: cus %d per_cu %d grid %d ws %zu need %zu\n", cus, per_cu, grid, ws_size, (size_t)WS_END);
    }
    if (grid < 0) return;
    Params p{};
    for (int i = 0; i < 23; ++i) p.in[i] = (const float*)d_in[i];
    p.out = (float*)d_out; p.ws = (unsigned char*)d_ws; p.p4m = 15;
#if MK_MULTI
#ifndef DUPMASK
#define DUPMASK 0
#endif
#ifndef DUP_P4M
#define DUP_P4M 15
#endif
    for (int ph = 0; ph < NPHASE; ++ph) for (int r = 0; r < 1 + ((DUPMASK >> ph) & 1); ++r) { p.ph_lo = ph; p.ph_hi = ph + 1; p.p4m = (r == 1 && ph == 4) ? DUP_P4M : 15; hipLaunchKernelGGL(fwd_mega, dim3(grid), dim3(512), LDS_BYTES, stream, p); }
#else
    p.ph_lo = 0; p.ph_hi = NPHASE;
    (void)hipMemsetAsync((unsigned char*)d_ws + WS_BAR, 0, 16384, stream);
    void* args[] = {&p};
    hipError_t e = hipLaunchCooperativeKernel((const void*)fwd_mega, dim3(grid), dim3(512), args, LDS_BYTES, stream);
    if (e != hipSuccess) fprintf(stderr, "cooperative launch failed: %s (grid %d)\n", hipGetErrorString(e), grid);
#endif
}
```

```cpp
#include <hip/hip_runtime.h>
#include <hip/hip_cooperative_groups.h>
#include <cstdio>
#include <cstdint>
namespace cg = cooperative_groups;

#define LAS __attribute__((address_space(3)))
typedef unsigned short bf16_t;
typedef short bf16x8 __attribute__((ext_vector_type(8)));
typedef float f32x4 __attribute__((ext_vector_type(4)));
typedef unsigned u32x4 __attribute__((ext_vector_type(4)));
typedef unsigned u32x2 __attribute__((ext_vector_type(2)));

constexpr int D = 2048, SP = 8192, NB = 128, TS = 4, MS = NB * TS, MTOT = SP + MS;
constexpr int NIN = 5632, INW = 5640, DFF = 5632, NMOD = 12288;
constexpr int C_AQ = 0, C_AK = 1024, C_AV = 1280, C_MQ = 1536, C_MK = 2560, C_MV = 3584, C_MO = 4608;
constexpr float EPS = 1e-6f;
constexpr int LC = 256, NCH = SP / LC;

constexpr size_t al256(size_t x) { return (x + 255) & ~(size_t)255; }
constexpr size_t WS_WADA = 0;
constexpr size_t WS_WIN = WS_WADA + (size_t)NMOD * D * 2;
constexpr size_t WS_WOUT = WS_WIN + (size_t)NIN * D * 2;
constexpr size_t WS_WGU = WS_WOUT + (size_t)D * D * 2;
constexpr size_t WS_WDN = WS_WGU + (size_t)2 * DFF * D * 2;
constexpr size_t WS_SILU = WS_WDN + (size_t)D * DFF * 2;
constexpr size_t WS_MOD = WS_SILU + (size_t)256 * D * 2;
constexpr size_t WS_H = al256(WS_MOD + (size_t)129 * NMOD * 4);
constexpr size_t WS_GATES = WS_H + (size_t)MTOT * D * 2;
constexpr size_t WS_P = al256(WS_GATES + (size_t)MTOT * 8 * 4);
constexpr size_t WS_MIX = WS_P + (size_t)MTOT * NIN * 2;
constexpr size_t WS_X1 = WS_MIX + (size_t)MTOT * D * 2;
constexpr size_t WS_ROPE = WS_X1 + (size_t)MTOT * D * 4;
constexpr size_t WS_WG = al256(WS_ROPE + (size_t)8196 * 16 * 4);
constexpr size_t WS_BC = WS_WG + (size_t)8 * D * 4;
constexpr size_t WS_BW = WS_BC + (size_t)4 * SP * 4;
constexpr size_t WS_MR = WS_BW + (size_t)4 * SP * 4;
constexpr size_t WS_U = WS_MR + (size_t)4 * SP * 4;
constexpr size_t WS_UN = WS_U + (size_t)NCH * 4 * 65536 * 4;
constexpr size_t WS_CST = WS_UN + (size_t)NCH * 4 * 256 * 4;
constexpr size_t WS_NST = WS_CST + (size_t)NCH * 4 * 65536 * 2;
constexpr size_t WS_PART = WS_NST + (size_t)NCH * 4 * 256 * 4;
constexpr size_t WS_BAR = WS_PART + (size_t)11 * MS * D * 4;
constexpr size_t WS_SSQ = WS_BAR + 16384;
constexpr size_t WS_END = WS_SSQ + (size_t)256 * 256 * 4;
constexpr size_t WS_PCNT = WS_BAR + 14336;

constexpr size_t O_Y = 0;
constexpr size_t O_KWP = (size_t)MTOT * D;
constexpr size_t O_VWP = O_KWP + 32768;
constexpr size_t O_CP = O_VWP + 32768;
constexpr size_t O_NP = O_CP + 262144;
constexpr size_t O_MP = O_NP + 1024;
constexpr size_t O_KWS = O_MP + 4;
constexpr size_t O_VWS = O_KWS + (size_t)NB * 128 * 256;
constexpr size_t O_CS = O_VWS + (size_t)NB * 128 * 256;
constexpr size_t O_NS = O_CS + (size_t)NB * 4 * 65536;
constexpr size_t O_MS = O_NS + (size_t)NB * 4 * 256;
constexpr size_t O_END = O_MS + (size_t)NB * 4;

constexpr int LDS_BYTES = 147456;
constexpr int NPHASE = 12;

struct Params { const float* in[23]; float* out; unsigned char* ws; int ph_lo, ph_hi, p4m, pad; };

__device__ __forceinline__ unsigned cvt_pk_bf16(float lo, float hi) { unsigned r; asm volatile("v_cvt_pk_bf16_f32 %0, %1, %2" : "=v"(r) : "v"(lo), "v"(hi)); return r; }
__device__ __forceinline__ float bf_lo(unsigned u) { return __uint_as_float(u << 16); }
__device__ __forceinline__ float bf_hi(unsigned u) { return __uint_as_float(u & 0xffff0000u); }
__device__ __forceinline__ float bf2f(bf16_t h) { return __uint_as_float((unsigned)h << 16); }
__device__ __forceinline__ float wave_sum(float v) {
#pragma unroll
    for (int o = 32; o >= 1; o >>= 1) v += __shfl_xor(v, o);
    return v;
}
__device__ __forceinline__ float wave_max(float v) {
#pragma unroll
    for (int o = 32; o >= 1; o >>= 1) v = fmaxf(v, __shfl_xor(v, o));
    return v;
}
__device__ __forceinline__ void lds_add(LAS float* p, float v) { __hip_atomic_fetch_add(p, v, __ATOMIC_RELAXED, __HIP_MEMORY_SCOPE_WORKGROUP); }
__device__ __forceinline__ float sigmoidf_(float x) { return 1.f / (1.f + __expf(-x)); }
__device__ __forceinline__ float logsigmoid_(float x) { return fminf(x, 0.f) - log1pf(expf(-fabsf(x))); }
__device__ __forceinline__ float logsigmoid_fast(float x) { return fminf(x, 0.f) - __logf(1.f + __expf(-fabsf(x))); }
__device__ __forceinline__ void unpack8(const u32x4 v, float (&f)[8]) {
    f[0] = bf_lo(v.x); f[1] = bf_hi(v.x); f[2] = bf_lo(v.y); f[3] = bf_hi(v.y); f[4] = bf_lo(v.z); f[5] = bf_hi(v.z); f[6] = bf_lo(v.w); f[7] = bf_hi(v.w);
}
__device__ __forceinline__ u32x4 pack8(const float (&f)[8]) {
    u32x4 r; r.x = cvt_pk_bf16(f[0], f[1]); r.y = cvt_pk_bf16(f[2], f[3]); r.z = cvt_pk_bf16(f[4], f[5]); r.w = cvt_pk_bf16(f[6], f[7]); return r;
}
__device__ __forceinline__ void zip8(const u32x4 a, const u32x4 b, unsigned (&w)[8]) {
    w[0] = (a.x & 0xffffu) | (b.x << 16); w[1] = (a.x >> 16) | (b.x & 0xffff0000u); w[2] = (a.y & 0xffffu) | (b.y << 16); w[3] = (a.y >> 16) | (b.y & 0xffff0000u);
    w[4] = (a.z & 0xffffu) | (b.z << 16); w[5] = (a.z >> 16) | (b.z & 0xffff0000u); w[6] = (a.w & 0xffffu) | (b.w << 16); w[7] = (a.w >> 16) | (b.w & 0xffff0000u);
}
__device__ __forceinline__ void rope8(float (&own)[8], const float (&oth)[8], const float* cs, int dg) {
#pragma unroll
    for (int i = 0; i < 8; ++i) { const float c = cs[i], s = cs[8 + i]; own[i] = (dg == 0) ? own[i] * c - oth[i] * s : own[i] * c + oth[i] * s; }
}

#define XB_TMO      128
#define XB_XCNT(j)  (256  + 64 * (j))
#define XB_XSUB(j)  (1280 + 64 * (j))
#define XB_XGEN(j)  (2304 + 64 * (j))
#define XB_TOP      3328
#define XB_TOPGEN   3392
#define XCD_BAR_WORDS 3456
#define XB_SPIN_CAP (1u << 18)

__device__ __forceinline__ unsigned xb_ld(unsigned* p)              { return __hip_atomic_load(p, __ATOMIC_RELAXED, __HIP_MEMORY_SCOPE_AGENT); }
__device__ __forceinline__ unsigned xb_add(unsigned* p, unsigned v) { return __hip_atomic_fetch_add(p, v, __ATOMIC_RELAXED, __HIP_MEMORY_SCOPE_AGENT); }
__device__ __forceinline__ unsigned xb_xcc_id() { return (unsigned)__builtin_amdgcn_s_getreg((3 << 11) | 20) & 0xFu; }
#define XB_SPIN(cond, bar) do { unsigned _sp = 0; while (cond) { __builtin_amdgcn_s_sleep(1); \
    if ((++_sp & 255u) == 0u) { if (xb_ld(&(bar)[XB_TMO])) break; if (_sp > XB_SPIN_CAP) { (void)xb_add(&(bar)[XB_TMO], 1u); break; } } } } while (0)

struct XcdBarrier {
    unsigned* bar; unsigned x;
    volatile LAS unsigned* st;
};

__device__ __forceinline__ XcdBarrier xcd_barrier_post(unsigned* bar, volatile LAS unsigned* st) {
    XcdBarrier b; b.bar = bar; b.x = xb_xcc_id(); b.st = st;
    if (threadIdx.x == 0) (void)xb_add(&bar[XB_XCNT(b.x)], 1u);
    return b;
}
__device__ __forceinline__ void xcd_barrier_complete(unsigned* bar, unsigned x, unsigned& nloc, unsigned& nx) {
    const unsigned G = gridDim.x * gridDim.y * gridDim.z;
    unsigned sum, cnt, mine, sp = 0u;
    for (;;) {
        sum = 0u; cnt = 0u; mine = 0u;
#pragma unroll
        for (unsigned j = 0; j < 16; ++j) { const unsigned c = xb_ld(&bar[XB_XCNT(j)]); sum += c; cnt += (c > 0u) ? 1u : 0u; mine = (j == x) ? c : mine; }
        if (sum == G) break;
        __builtin_amdgcn_s_sleep(1);
        if ((++sp & 255u) == 0u) { if (xb_ld(&bar[XB_TMO])) break; if (sp > XB_SPIN_CAP) { (void)xb_add(&bar[XB_TMO], 1u); break; } }
    }
    nloc = mine > 0u ? mine : 1u; nx = cnt > 0u ? cnt : 1u;
}

__device__ __forceinline__ void xcd_barrier(const XcdBarrier& b) {
    asm volatile("s_waitcnt vmcnt(0)" ::: "memory");
    __syncthreads();
    if (threadIdx.x == 0) {
        unsigned* bar = b.bar;
        __builtin_amdgcn_s_waitcnt(0);
        unsigned nloc = b.st[0], nx = b.st[1];
        if (nloc == 0u) { xcd_barrier_complete(bar, b.x, nloc, nx); b.st[0] = nloc; b.st[1] = nx; }
        const unsigned old = xb_add(&bar[XB_XSUB(b.x)], 1u);
        const unsigned gen = old / nloc;
        if (old + 1u == (gen + 1u) * nloc) {
            __builtin_amdgcn_fence(__ATOMIC_RELEASE, "agent");
            asm volatile("s_waitcnt vmcnt(0)" ::: "memory");
            const unsigned og = xb_add(&bar[XB_TOP], 1u);
            const unsigned tg = og / nx;
            if (og + 1u == (tg + 1u) * nx) xb_add(&bar[XB_TOPGEN], 1u);
            else XB_SPIN(xb_ld(&bar[XB_TOPGEN]) == tg, bar);
            __builtin_amdgcn_fence(__ATOMIC_ACQUIRE, "agent");
            xb_add(&bar[XB_XGEN(b.x)], 1u);
            asm volatile("s_waitcnt vmcnt(0)" ::: "memory");
        } else {
            XB_SPIN(xb_ld(&bar[XB_XGEN(b.x)]) == gen, bar);
            __builtin_amdgcn_fence(__ATOMIC_ACQUIRE, "agent");
            asm volatile("s_waitcnt vmcnt(0)" ::: "memory");
        }
    }
    __syncthreads();
}


__device__ __forceinline__ void grid_bar(unsigned* ctr, unsigned target) {
    __syncthreads();
    if (threadIdx.x == 0) {
        __builtin_amdgcn_fence(__ATOMIC_RELEASE, "agent");
        __hip_atomic_fetch_add(ctr, 1u, __ATOMIC_RELAXED, __HIP_MEMORY_SCOPE_AGENT);
        while (__hip_atomic_load(ctr, __ATOMIC_RELAXED, __HIP_MEMORY_SCOPE_AGENT) < target) __builtin_amdgcn_s_sleep(2);
        __builtin_amdgcn_fence(__ATOMIC_ACQUIRE, "agent");
    }
    __syncthreads();
}

namespace pg8 {
constexpr int BM = 256, BK = 64, HALF = 128, HTB = HALF * BK * 2, STAGE_BYTES = 8 * HTB, NXCD = 8, WGM = 8;
__host__ __device__ __forceinline__ int lds_byte(int r, int c) { const int st = (r >> 4) * 2 + (c >> 5), rr = r & 15, cc = c & 31, ob = rr * 64 + cc * 2; return st * 1024 + (ob ^ (((ob >> 9) & 1) << 5)); }
__host__ __device__ __forceinline__ void stage_rc(int b, int& R, int& C) { const int st = b / 1024, sb = b % 1024, swz = sb ^ (((sb >> 9) & 1) << 5); R = (st >> 1) * 16 + swz / 64; C = (st & 1) * 32 + (swz % 64) / 2; }
__host__ __device__ __forceinline__ int perm32(int rho) { const int n = rho >> 4, i = rho & 15; return 8 * (i >> 2) + 4 * n + (i & 3); }
struct Unit { int pm, pn, kz, nt; };
struct Gemm { const bf16_t* A; const bf16_t* Bt; int lda, ldb; };
struct StaticOrder {
    int nM, nN, nwg, G, c, nt;
    __device__ void init(int M, int N, int G_, int c_, int nt_) { nM = M / BM; nN = N / BM; nwg = nM * nN; G = G_; c = c_; nt = nt_; }
    __device__ bool next(int i, Unit& u) const {
        const long L = (long)i * G + c; if (L >= nwg) return false;
        int wgid = (int)L; { const int q = nwg / NXCD, r = nwg % NXCD, xcd = wgid % NXCD, off = wgid / NXCD; wgid = (xcd < r ? xcd * (q + 1) : r * (q + 1) + (xcd - r) * q) + off; }
        const int nig = WGM * nN, gid = wgid / nig, fm = gid * WGM, gsz = (nM - fm) < WGM ? (nM - fm) : WGM;
        u.pm = fm + ((wgid % nig) % gsz); u.pn = (wgid % nig) / gsz; u.kz = 0; u.nt = nt; return true;
    }
};
struct SplitKOrder {
    int nN, nz, G, c, nt;
    __device__ bool next(int i, Unit& u) const { const int L = i * G + c; if (L >= nN * nz) return false; u.pm = 0; u.pn = L % nN; u.kz = L / nN; u.nt = nt; return true; }
};
struct PromptSampleOrder {
    int G, c, ntfull, nz;
    __device__ bool next(int i, Unit& u) const {
        const int L = i * G + c; if (L >= 256 + 16 * nz) return false;
        if (L < 256) { int wgid = L; { const int q = 256 / NXCD, xcd = wgid % NXCD, off = wgid / NXCD; wgid = xcd * q + off; }
            const int nig = WGM * 8, gid = wgid / nig, fm = gid * WGM; u.pm = fm + ((wgid % nig) % WGM); u.pn = (wgid % nig) / WGM; u.kz = 0; u.nt = ntfull; }
        else { const int idx = L - 256; u.pn = idx & 7; u.pm = 32 + ((idx >> 3) & 1); u.kz = idx >> 4; u.nt = ntfull / nz; }
        return true; }
};

template <class Epi, class Sched>
__device__ __forceinline__ void gemm_phase(LAS unsigned char* lds, const Gemm g, const Sched& S, const Epi& E) {
    const int tid = threadIdx.x, wid = __builtin_amdgcn_readfirstlane(tid >> 6), lane = tid & 63, wr = wid >> 2, wc = wid & 3, fr = lane & 15, fq = lane >> 4;
    unsigned voffA[2], voffB[2];
#pragma unroll
    for (int i = 0; i < 2; ++i) { int R, C; stage_rc(tid * 16 + i * 8192, R, C); const int Rb = Epi::PERM ? ((R & ~31) + perm32(R & 31)) : R;
        voffA[i] = (unsigned)(R * g.lda + C) * 2u; voffB[i] = (unsigned)(Rb * g.ldb + C) * 2u; }
    const size_t kstep = (size_t)(BK * 2);
    const size_t hstepA = (size_t)HALF * g.lda * 2, hstepB = (size_t)HALF * g.ldb * 2;
    const size_t tstepA = 2 * hstepA, tstepB = 2 * hstepB;
    const unsigned ldsw = (unsigned)wid * 1024u;
    const int aoff = lds_byte(wr * 64 + fr, fq * 8), boff = lds_byte(wc * 32 + fr, fq * 8);
#define PG8_SA(b, h) (((b) * 2 + (h)) * HTB)
#define PG8_SB(b, h) ((4 + (b) * 2 + (h)) * HTB)
#define PG8_STAGE(bufoff, gbase, voff) do { _Pragma("unroll") for (int _i = 0; _i < 2; ++_i) \
        __builtin_amdgcn_global_load_lds((const unsigned*)((const char*)(gbase) + (voff)[_i]), (LAS unsigned*)(lds + (bufoff) + ldsw + _i * 8192), 16, 0, 0); } while (0)
#define PG8_LDA(dst, b, h) do { _Pragma("unroll") for (int m = 0; m < 4; ++m) _Pragma("unroll") for (int k = 0; k < 2; ++k) dst[m][k] = *(const LAS bf16x8*)(lds + PG8_SA(b, h) + aoff + m * 2048 + k * 1024); } while (0)
#define PG8_LDB(dst, b, h) do { _Pragma("unroll") for (int n = 0; n < 2; ++n) _Pragma("unroll") for (int k = 0; k < 2; ++k) dst[n][k] = *(const LAS bf16x8*)(lds + PG8_SB(b, h) + boff + n * 2048 + k * 1024); } while (0)
#define PG8_MMA(ai, bj, At, Bt) do { __builtin_amdgcn_s_setprio(1); _Pragma("unroll") for (int m = 0; m < 4; ++m) _Pragma("unroll") for (int n = 0; n < 2; ++n) _Pragma("unroll") for (int k = 0; k < 2; ++k) \
        acc[ai][bj][m][n] = __builtin_amdgcn_mfma_f32_16x16x32_bf16(Bt[n][k], At[m][k], acc[ai][bj][m][n], 0, 0, 0); __builtin_amdgcn_s_setprio(0); } while (0)
#define PG8_WAIT_V(n) asm volatile("s_waitcnt vmcnt(" #n ")" ::: "memory")
#define PG8_WAIT_L(n) asm volatile("s_waitcnt lgkmcnt(" #n ")" ::: "memory")
#define PG8_BAR __builtin_amdgcn_s_barrier()
#define PG8_SCHED __builtin_amdgcn_sched_barrier(0)
    Unit cur, nxt; int ui = 0;
    if (!S.next(0, cur)) return;
    f32x4 acc[2][2][4][2];
#pragma unroll
    for (int a = 0; a < 2; ++a)
#pragma unroll
        for (int b = 0; b < 2; ++b)
#pragma unroll
            for (int m = 0; m < 4; ++m)
#pragma unroll
                for (int n = 0; n < 2; ++n) acc[a][b][m][n] = (f32x4){0.f, 0.f, 0.f, 0.f};
    bf16x8 At[4][2], B0[2][2], B1[2][2];
    const char* cA = (const char*)g.A + (size_t)cur.pm * tstepA + (size_t)cur.kz * cur.nt * (BK * 2); const char* cB = (const char*)g.Bt + (size_t)cur.pn * tstepB + (size_t)cur.kz * cur.nt * (BK * 2);
    PG8_STAGE(PG8_SB(0, 0), cB, voffB); PG8_STAGE(PG8_SB(0, 1), cB + hstepB, voffB); PG8_STAGE(PG8_SA(0, 0), cA, voffA); PG8_STAGE(PG8_SA(0, 1), cA + hstepA, voffA);
    if (wr == 1) PG8_BAR;
    PG8_WAIT_V(2); PG8_BAR;
    PG8_STAGE(PG8_SB(1, 0), cB + kstep, voffB); PG8_STAGE(PG8_SA(1, 0), cA + kstep, voffA); PG8_STAGE(PG8_SB(1, 1), cB + hstepB + kstep, voffB);
    PG8_WAIT_V(6); PG8_BAR;
    for (;;) {
        const bool has_next = S.next(ui + 1, nxt);
        const char* nA = has_next ? (const char*)g.A + (size_t)nxt.pm * tstepA + (size_t)nxt.kz * nxt.nt * (BK * 2) : cA; const char* nB = has_next ? (const char*)g.Bt + (size_t)nxt.pn * tstepB + (size_t)nxt.kz * nxt.nt * (BK * 2) : cB;
        const int nt = cur.nt;
        for (int t = 0; t < nt; t += 2) {
            const bool last = (t == nt - 2);
            const char* a1 = cA + (size_t)(t + 1) * kstep;
            const char* a2 = last ? nA : cA + (size_t)(t + 2) * kstep; const char* b2 = last ? nB : cB + (size_t)(t + 2) * kstep;
            const char* a3 = a2 + kstep; const char* b3 = b2 + kstep;
            PG8_LDB(B0, 0, 0); PG8_LDB(B1, 0, 1); PG8_SCHED; PG8_LDA(At, 0, 0); PG8_STAGE(PG8_SA(1, 1), a1 + hstepA, voffA);
            PG8_WAIT_V(8); PG8_WAIT_L(0); PG8_BAR; PG8_MMA(0, 0, At, B0); PG8_MMA(0, 1, At, B1); PG8_BAR; PG8_SCHED;
            PG8_LDA(At, 0, 1); PG8_STAGE(PG8_SB(0, 0), b2, voffB); PG8_STAGE(PG8_SB(0, 1), b2 + hstepB, voffB); PG8_STAGE(PG8_SA(0, 0), a2, voffA);
            PG8_WAIT_V(8); PG8_WAIT_L(0); PG8_BAR; PG8_MMA(1, 0, At, B0); PG8_MMA(1, 1, At, B1); PG8_BAR; PG8_SCHED;
            PG8_LDB(B0, 1, 0); PG8_LDB(B1, 1, 1); PG8_SCHED; PG8_LDA(At, 1, 0); PG8_STAGE(PG8_SA(0, 1), a2 + hstepA, voffA);
            PG8_WAIT_V(8); PG8_WAIT_L(0); PG8_BAR; PG8_MMA(0, 0, At, B0); PG8_MMA(0, 1, At, B1); PG8_BAR; PG8_SCHED;
            PG8_LDA(At, 1, 1); PG8_STAGE(PG8_SB(1, 0), b3, voffB); PG8_STAGE(PG8_SB(1, 1), b3 + hstepB, voffB); PG8_STAGE(PG8_SA(1, 0), a3, voffA);
            PG8_WAIT_V(8); PG8_WAIT_L(0); PG8_BAR; PG8_MMA(1, 0, At, B0); PG8_MMA(1, 1, At, B1); PG8_BAR; PG8_SCHED;
        }
        if (wr == 0) PG8_BAR;
        E(acc, cur, wr, wc, fr, fq);
        if (!has_next) break;
#pragma unroll
        for (int a = 0; a < 2; ++a)
#pragma unroll
            for (int b = 0; b < 2; ++b)
#pragma unroll
                for (int m = 0; m < 4; ++m)
#pragma unroll
                    for (int n = 0; n < 2; ++n) acc[a][b][m][n] = (f32x4){0.f, 0.f, 0.f, 0.f};
        cur = nxt; cA = nA; cB = nB; ++ui;
        if (wr == 1) PG8_BAR;
    }
    PG8_WAIT_V(0);
    PG8_BAR;
#undef PG8_SA
#undef PG8_SB
#undef PG8_STAGE
#undef PG8_LDA
#undef PG8_LDB
#undef PG8_MMA
#undef PG8_WAIT_V
#undef PG8_WAIT_L
#undef PG8_BAR
#undef PG8_SCHED
}

struct EpiMod {
    static constexpr bool PERM = false;
    float* mod; const float* bias;
    __device__ __forceinline__ void operator()(const f32x4 (&acc)[2][2][4][2], const Unit& u, int wr, int wc, int fr, int fq) const {
        const int col0 = u.pn * BM + wc * 32 + 4 * fq;
        f32x4 bv[2][2];
#pragma unroll
        for (int bj = 0; bj < 2; ++bj)
#pragma unroll
            for (int n = 0; n < 2; ++n) bv[bj][n] = *(const f32x4*)(bias + col0 + bj * HALF + n * 16);
#pragma unroll
        for (int ai = 0; ai < 2; ++ai)
#pragma unroll
            for (int m = 0; m < 4; ++m) { const int row = ai * HALF + wr * 64 + m * 16 + fr; if (row < 129) {
#pragma unroll
                for (int bj = 0; bj < 2; ++bj)
#pragma unroll
                    for (int n = 0; n < 2; ++n) { const int c = col0 + bj * HALF + n * 16; *(f32x4*)(mod + (size_t)row * NMOD + c) = acc[ai][bj][m][n] + bv[bj][n]; } } }
    }
};
struct EpiBf16 {
    static constexpr bool PERM = true;
    bf16_t* O; int ldc;
    __device__ __forceinline__ void operator()(const f32x4 (&acc)[2][2][4][2], const Unit& u, int wr, int wc, int fr, int fq) const {
        const int row0 = u.pm * BM + wr * 64 + fr, col0 = u.pn * BM + wc * 32 + 8 * fq;
#pragma unroll
        for (int ai = 0; ai < 2; ++ai)
#pragma unroll
            for (int m = 0; m < 4; ++m) { bf16_t* rowp = O + (size_t)(row0 + ai * HALF + m * 16) * ldc + col0;
#pragma unroll
                for (int bj = 0; bj < 2; ++bj) { const f32x4 v0 = acc[ai][bj][m][0], v1 = acc[ai][bj][m][1];
                    u32x4 w; w.x = cvt_pk_bf16(v0[0], v0[1]); w.y = cvt_pk_bf16(v0[2], v0[3]); w.z = cvt_pk_bf16(v1[0], v1[1]); w.w = cvt_pk_bf16(v1[2], v1[3]);
                    *(u32x4*)(rowp + bj * HALF) = w; } }
    }
};
struct EpiGU {
    static constexpr bool PERM = true;
    bf16_t* O; int ldc;
    __device__ __forceinline__ void operator()(const f32x4 (&acc)[2][2][4][2], const Unit& u, int wr, int wc, int fr, int fq) const {
        const int row0 = u.pm * BM + wr * 64 + fr, col0 = u.pn * HALF + wc * 32 + 8 * fq;
#pragma unroll
        for (int ai = 0; ai < 2; ++ai)
#pragma unroll
            for (int m = 0; m < 4; ++m) { bf16_t* rowp = O + (size_t)(row0 + ai * HALF + m * 16) * ldc + col0;
                float r[8];
#pragma unroll
                for (int n = 0; n < 2; ++n)
#pragma unroll
                    for (int e = 0; e < 4; ++e) { const float gt = acc[ai][0][m][n][e], up = acc[ai][1][m][n][e]; r[n * 4 + e] = gt * __builtin_amdgcn_rcpf(1.f + __expf(-gt)) * up; }
                *(u32x4*)rowp = pack8(r); }
    }
};
__device__ __forceinline__ void store_partials(const f32x4 (&acc)[2][2][4][2], const Unit& u, int row0, int col0, const float* gate, float* part) {
    int poff = (u.kz * MS + (row0 - SP)) * D + col0; asm volatile("" : "+v"(poff));
#pragma unroll
    for (int am = 0; am < 4; ++am) { f32x4 gv[2][2][2];
#pragma unroll
        for (int m2 = 0; m2 < 2; ++m2) { const int rr = row0 - SP + (am >> 1) * HALF + ((am & 1) * 2 + m2) * 16; const int go = (rr >> 2) * NMOD + col0;
#pragma unroll
            for (int bj = 0; bj < 2; ++bj)
#pragma unroll
                for (int n = 0; n < 2; ++n) gv[m2][bj][n] = *(const f32x4*)(gate + (go + bj * HALF + n * 16)); }
#pragma unroll
        for (int m2 = 0; m2 < 2; ++m2) { const int po = poff + ((am >> 1) * HALF + ((am & 1) * 2 + m2) * 16) * D;
#pragma unroll
            for (int bj = 0; bj < 2; ++bj)
#pragma unroll
                for (int n = 0; n < 2; ++n) *(f32x4*)(part + (po + bj * HALF + n * 16)) = gv[m2][bj][n] * acc[am >> 1][bj][(am & 1) * 2 + m2][n]; } }
}
struct EpiRes {
    static constexpr bool PERM = false;
    float* out; const float* res0; const float* res1; const float* gate; float* part;
    __device__ __forceinline__ void operator()(const f32x4 (&acc)[2][2][4][2], const Unit& u, int wr, int wc, int fr, int fq) const {
        const int row0 = u.pm * BM + wr * 64 + fr, col0 = u.pn * BM + wc * 32 + 4 * fq;
        if (u.pm >= 32) { store_partials(acc, u, row0, col0, gate, part); return; }
        f32x4 gv[2][2];
#pragma unroll
        for (int bj = 0; bj < 2; ++bj)
#pragma unroll
            for (int n = 0; n < 2; ++n) gv[bj][n] = *(const f32x4*)(gate + (size_t)128 * NMOD + col0 + bj * HALF + n * 16);
        int roff = row0 * D + col0; asm volatile("" : "+v"(roff));
#pragma unroll
        for (int am = 0; am < 4; ++am) { f32x4 rv[2][2][2];
#pragma unroll
            for (int m2 = 0; m2 < 2; ++m2)
#pragma unroll
                for (int bj = 0; bj < 2; ++bj)
#pragma unroll
                    for (int n = 0; n < 2; ++n) rv[m2][bj][n] = *(const f32x4*)(res0 + (roff + ((am >> 1) * HALF + ((am & 1) * 2 + m2) * 16) * D + bj * HALF + n * 16));
#pragma unroll
            for (int m2 = 0; m2 < 2; ++m2)
#pragma unroll
                for (int bj = 0; bj < 2; ++bj)
#pragma unroll
                    for (int n = 0; n < 2; ++n) *(f32x4*)(out + (roff + ((am >> 1) * HALF + ((am & 1) * 2 + m2) * 16) * D + bj * HALF + n * 16)) = rv[m2][bj][n] + gv[bj][n] * acc[am >> 1][bj][(am & 1) * 2 + m2][n]; }
    }
};
struct EpiResNorm {
    static constexpr bool PERM = false;
    float* out; const float* res0; const float* gate; float* part; const float* nw; float* ssq; unsigned* pcnt; LAS float* red;
    __device__ __forceinline__ void operator()(const f32x4 (&acc)[2][2][4][2], const Unit& u, int wr, int wc, int fr, int fq) const {
        const int row0 = u.pm * BM + wr * 64 + fr, col0 = u.pn * BM + wc * 32 + 4 * fq, tid = threadIdx.x;
        if (u.pm >= 32) { store_partials(acc, u, row0, col0, gate, part); return; }
        const float* gp = gate + (size_t)128 * NMOD;
        int roff = row0 * D + col0; asm volatile("" : "+v"(roff));
#pragma unroll
        for (int ai = 0; ai < 2; ++ai)
#pragma unroll
            for (int m = 0; m < 4; ++m) { const int ro = roff + (ai * HALF + m * 16) * D; float ps = 0.f;
#pragma unroll
                for (int bj = 0; bj < 2; ++bj)
#pragma unroll
                    for (int n = 0; n < 2; ++n) { const int o = bj * HALF + n * 16; const f32x4 rv = *(const f32x4*)(res0 + (ro + o)), gv = *(const f32x4*)(gp + (col0 + o));
                        const f32x4 v = rv + gv * acc[ai][bj][m][n]; ps += v[0] * v[0] + v[1] * v[1] + v[2] * v[2] + v[3] * v[3]; }
                ps += __shfl_xor(ps, 16); ps += __shfl_xor(ps, 32);
                if (fq == 0) red[(ai * HALF + wr * 64 + m * 16 + fr) * 4 + wc] = ps; }
        __syncthreads();
        if (tid < 256) { const f32x4 r4 = *(const LAS f32x4*)(red + tid * 4);
            __hip_atomic_store(ssq + (size_t)(u.pm * 8 + u.pn) * 256 + tid, r4[0] + r4[1] + r4[2] + r4[3], __ATOMIC_RELAXED, __HIP_MEMORY_SCOPE_AGENT); }
        asm volatile("s_waitcnt vmcnt(0)" ::: "memory");
        __syncthreads();
        if (tid == 0) { __hip_atomic_fetch_add(pcnt + u.pm, 1u, __ATOMIC_RELAXED, __HIP_MEMORY_SCOPE_AGENT); unsigned sp = 0;
            while (__hip_atomic_load(pcnt + u.pm, __ATOMIC_RELAXED, __HIP_MEMORY_SCOPE_AGENT) < 8u && ++sp < (1u << 22)) __builtin_amdgcn_s_sleep(1); }
        __syncthreads();
        if (tid < 256) { float tot = 0.f; const float* sp = ssq + (size_t)(u.pm * 8) * 256 + tid;
#pragma unroll 1
            for (int j = 0; j < 8; ++j) { tot += __hip_atomic_load(sp, __ATOMIC_RELAXED, __HIP_MEMORY_SCOPE_AGENT); sp += 256; }
            red[1024 + tid] = rsqrtf(tot * (1.f / D) + EPS); }
        __syncthreads();
        int woff = row0 * D + col0; asm volatile("" : "+v"(woff));
        f32x4 gw[2][2], ww[2][2];
#pragma unroll
        for (int bj = 0; bj < 2; ++bj)
#pragma unroll
            for (int n = 0; n < 2; ++n) { gw[bj][n] = *(const f32x4*)(gp + (col0 + bj * HALF + n * 16)); ww[bj][n] = *(const f32x4*)(nw + (col0 + bj * HALF + n * 16)); }
#pragma unroll
        for (int am = 0; am < 4; ++am) { f32x4 rv[2][2][2]; float rr[2];
#pragma unroll
            for (int m2 = 0; m2 < 2; ++m2) { rr[m2] = red[1024 + (am >> 1) * HALF + wr * 64 + ((am & 1) * 2 + m2) * 16 + fr];
#pragma unroll
                for (int bj = 0; bj < 2; ++bj)
#pragma unroll
                    for (int n = 0; n < 2; ++n) rv[m2][bj][n] = *(const f32x4*)(res0 + (woff + ((am >> 1) * HALF + ((am & 1) * 2 + m2) * 16) * D + bj * HALF + n * 16)); }
#pragma unroll
            for (int m2 = 0; m2 < 2; ++m2)
#pragma unroll
                for (int bj = 0; bj < 2; ++bj)
#pragma unroll
                    for (int n = 0; n < 2; ++n) *(f32x4*)(out + (woff + ((am >> 1) * HALF + ((am & 1) * 2 + m2) * 16) * D + bj * HALF + n * 16)) = (rv[m2][bj][n] + gw[bj][n] * acc[am >> 1][bj][(am & 1) * 2 + m2][n]) * rr[m2] * ww[bj][n]; }
    }
};
}

struct Frame {
    LAS unsigned char* lds;
    int tid, lane, wave, G, bid;
    const float* in[23];
    float* out; unsigned char* ws;
};

struct TileDesc { const float* src; bf16_t* dst; int ldn, K, k0, n0, kind; };
__device__ __forceinline__ TileDesc tile_desc(const Frame& F, int t) {
    unsigned char* ws = F.ws; TileDesc d; int NT, idx; d.kind = 0;
    if (t < 1536) { d.src = F.in[12]; d.ldn = NMOD; d.K = D; NT = 48; idx = t; d.dst = (bf16_t*)(ws + WS_WADA); }
    else if (t < 2240) { d.src = F.in[14]; d.ldn = INW; d.K = D; NT = 22; idx = t - 1536; d.dst = (bf16_t*)(ws + WS_WIN); }
    else if (t < 2496) { d.src = F.in[19]; d.ldn = D; d.K = D; NT = 8; idx = t - 2240; d.dst = (bf16_t*)(ws + WS_WOUT); }
    else if (t < 3200) { d.src = F.in[20]; d.ldn = DFF; d.K = D; NT = 22; idx = t - 2496; d.dst = (bf16_t*)(ws + WS_WGU); d.kind = 1; }
    else if (t < 3904) { d.src = F.in[21]; d.ldn = DFF; d.K = D; NT = 22; idx = t - 3200; d.dst = (bf16_t*)(ws + WS_WGU); d.kind = 2; }
    else { d.src = F.in[22]; d.ldn = D; d.K = DFF; NT = 8; idx = t - 3904; d.dst = (bf16_t*)(ws + WS_WDN); }
    d.n0 = (idx % NT) * 256; d.k0 = (idx / NT) * 64; return d;
}
__device__ __forceinline__ void convert_tiles(const Frame& F, int tlo, int thi, int wb, int nw) {
    LAS float* tile = (LAS float*)F.lds;
    int t = tlo + wb; if (t >= thi) return;
    TileDesc d = tile_desc(F, t);
    f32x4 v[8];
#pragma unroll
    for (int i = 0; i < 8; ++i) v[i] = __builtin_nontemporal_load((const f32x4*)(d.src + (size_t)(d.k0 + i * 8 + F.wave) * d.ldn + d.n0 + F.lane * 4));
    for (;;) {
#pragma unroll
        for (int i = 0; i < 8; ++i) { LAS float* tp = tile + (i * 8 + F.wave) * 257 + F.lane * 4; tp[0] = v[i][0]; tp[1] = v[i][1]; tp[2] = v[i][2]; tp[3] = v[i][3]; }
        __syncthreads();
        const int tn = t + nw; const bool more = tn < thi; TileDesc dn = d;
        if (more) { dn = tile_desc(F, tn);
#pragma unroll
            for (int i = 0; i < 8; ++i) v[i] = __builtin_nontemporal_load((const f32x4*)(dn.src + (size_t)(dn.k0 + i * 8 + F.wave) * dn.ldn + dn.n0 + F.lane * 4)); }
#pragma unroll
        for (int it = 0; it < 4; ++it) { const int item = it * 512 + F.tid, n = item >> 3, kg = item & 7;
            float f[8];
#pragma unroll
            for (int j = 0; j < 8; ++j) f[j] = tile[(kg * 8 + j) * 257 + n];
            const int nn = d.n0 + n; const int row = d.kind == 0 ? nn : (((nn >> 7) << 8) + (nn & 127) + (d.kind == 2 ? 128 : 0));
            *(u32x4*)(d.dst + (size_t)row * d.K + d.k0 + kg * 8) = pack8(f); }
        __syncthreads();
        if (!more) break;
        t = tn; d = dn;
    }
}

__device__ __forceinline__ void p0_prologue(const Frame& F) {
    unsigned char* ws = F.ws;
    convert_tiles(F, 0, 2496, F.bid, F.G);
    const int gt = F.bid * 512 + F.tid, GT = F.G * 512;
    { bf16_t* sc = (bf16_t*)(ws + WS_SILU);
      for (int i = gt; i < 256 * D / 2; i += GT) { const int r = (i * 2) >> 11, c = (i * 2) & 2047; float a = 0.f, b = 0.f;
          if (r < 128) { a = F.in[8][r * D + c]; b = F.in[8][r * D + c + 1]; } else if (r == 128) { a = F.in[7][c]; b = F.in[7][c + 1]; }
          a = a / (1.f + expf(-a)); b = b / (1.f + expf(-b));
          *(unsigned*)(sc + (size_t)i * 2) = cvt_pk_bf16(a, b); } }
    { float* rt = (float*)(ws + WS_ROPE);
      for (int i = gt; i < 8196 * 8; i += GT) { const int pi = i >> 3, f = i & 7; const int pos = pi < SP ? pi : 16384 + (pi - SP);
          const float inv = f == 0 ? 1.0f : f == 1 ? 0.1939227432012558f : f == 2 ? 0.03760603070259094f : f == 3 ? 0.007292664609849453f : f == 4 ? 0.0014142135623842478f : f == 5 ? 0.00027424818836152554f : f == 6 ? 5.318296098266728e-05f : 1.0313386155758053e-05f;
          const float ang = (float)pos * inv; const double a = (double)ang; const double k = rint(a * 0.15915494309189535); const float r = (float)(a - k * 6.283185307179586);
          rt[pi * 16 + f] = cosf(r); rt[pi * 16 + 8 + f] = sinf(r); } }
    { float* wg = (float*)(ws + WS_WG); for (int i = gt; i < 8 * D; i += GT) { const int j = i >> 11, c = i & 2047; wg[i] = F.in[14][(size_t)c * INW + NIN + j]; } }
}

__device__ __forceinline__ void kvwin_copy(const Frame& F, int gt, int GT) {
    const int per = 124 * 64;
    for (int i0 = gt; i0 < NB * per; i0 += 4 * GT) { f32x4 a[4], b[4]; size_t so[4], dof[4];
#pragma unroll
        for (int u = 0; u < 4; ++u) { const int i = i0 + u * GT; const int ii = i < NB * per ? i : 0; const int bb = ii / per, o = ii - bb * per; so[u] = (size_t)bb * 8192 + 256 + o; dof[u] = (size_t)bb * 8192 + o;
            a[u] = __builtin_nontemporal_load((const f32x4*)F.in[2] + so[u]); b[u] = __builtin_nontemporal_load((const f32x4*)F.in[3] + so[u]); }
#pragma unroll
        for (int u = 0; u < 4; ++u) { if (i0 + u * GT < NB * per) { __builtin_nontemporal_store(a[u], (f32x4*)(F.out + O_KWS) + dof[u]); __builtin_nontemporal_store(b[u], (f32x4*)(F.out + O_VWS) + dof[u]); } } }
}

template <bool GATES>
__device__ __forceinline__ void norm_mod_phase(const Frame& F, const float* src0, const float* src1, const float* nw, int sh_off, int sc_off, int nparts, float* x1out) {
    const float* mod = (const float*)(F.ws + WS_MOD);
    bf16_t* H = (bf16_t*)(F.ws + WS_H);
    LAS float* wg = (LAS float*)F.lds;
    if (GATES) { const f32x4* s = (const f32x4*)(F.ws + WS_WG); for (int i = F.tid; i < 8 * D / 4; i += 512) ((LAS f32x4*)wg)[i] = s[i]; __syncthreads(); }
    f32x4 av[8], shv[8];
    { const float* mr = mod + (size_t)128 * NMOD;
#pragma unroll
      for (int i = 0; i < 8; ++i) { const int c4 = i * 64 + F.lane; const f32x4 w = ((const f32x4*)nw)[c4], sc = ((const f32x4*)(mr + sc_off))[c4]; shv[i] = ((const f32x4*)(mr + sh_off))[c4]; av[i] = w * (sc + 1.f); } }
    for (int r = F.bid * 8 + F.wave; r < MTOT; r += F.G * 8) {
        const float* xr = r < SP ? src0 + (size_t)r * D : src1 + (size_t)(r - SP) * D;
        f32x4 xv[8]; float ss = 0.f;
#pragma unroll
        for (int i = 0; i < 8; ++i) xv[i] = ((const f32x4*)xr)[i * 64 + F.lane];
        if (r >= SP) { const float* mr = mod + (size_t)((r - SP) >> 2) * NMOD;
#pragma unroll
            for (int i = 0; i < 8; ++i) { const int c4 = i * 64 + F.lane; const f32x4 w = ((const f32x4*)nw)[c4], sc = ((const f32x4*)(mr + sc_off))[c4]; shv[i] = ((const f32x4*)(mr + sh_off))[c4]; av[i] = w * (sc + 1.f); }
            if (nparts > 0) {
                for (int z = 0; z < nparts; ++z) { const f32x4* pp = (const f32x4*)(F.ws + WS_PART) + ((size_t)z * MS + (r - SP)) * (D / 4);
#pragma unroll
                    for (int i = 0; i < 8; ++i) xv[i] += pp[i * 64 + F.lane]; }
#pragma unroll
                for (int i = 0; i < 8; ++i) ((f32x4*)(x1out + (size_t)(r - SP) * D))[i * 64 + F.lane] = xv[i]; } }
#pragma unroll
        for (int i = 0; i < 8; ++i) ss += xv[i][0] * xv[i][0] + xv[i][1] * xv[i][1] + xv[i][2] * xv[i][2] + xv[i][3] * xv[i][3];
        ss = wave_sum(ss);
        const float rstd = rsqrtf(ss * (1.f / D) + EPS);
        float g[8];
#pragma unroll
        for (int j = 0; j < 8; ++j) g[j] = 0.f;
#pragma unroll
        for (int i = 0; i < 8; ++i) { const int c4 = i * 64 + F.lane;
            f32x4 h;
#pragma unroll
            for (int e = 0; e < 4; ++e) h[e] = (xv[i][e] * rstd) * av[i][e] + shv[i][e];
            u32x2 pk; pk.x = cvt_pk_bf16(h[0], h[1]); pk.y = cvt_pk_bf16(h[2], h[3]);
            *(u32x2*)(H + (size_t)r * D + c4 * 4) = pk;
            if (GATES) {
#pragma unroll
                for (int j = 0; j < 8; ++j) { const f32x4 wv = ((const LAS f32x4*)(wg + j * D))[c4]; g[j] += h[0] * wv[0] + h[1] * wv[1] + h[2] * wv[2] + h[3] * wv[3]; } } }
        if (GATES) {
#pragma unroll
            for (int j = 0; j < 8; ++j) g[j] = wave_sum(g[j]);
            if (F.lane == 0) { float* gp = (float*)(F.ws + WS_GATES) + (size_t)r * 8;
                *(f32x4*)gp = (f32x4){g[0], g[1], g[2], g[3]}; *(f32x4*)(gp + 4) = (f32x4){g[4], g[5], g[6], g[7]}; } }
    }
    if (GATES) __syncthreads();
}

__device__ __forceinline__ void mlstm_scan(const Frame& F, int hh) {
    LAS float* sB = (LAS float*)F.lds;
    LAS float* sW = sB + SP;
    LAS float* sM = sW + SP;
    LAS float* tot = sM + SP;
    const float* gates = (const float*)(F.ws + WS_GATES);
    const float big = F.in[15][hh], bfg = F.in[16][hh];
    float cB = 0.f, cM = -INFINITY;
    for (int it = 0; it < 16; ++it) { const int t = F.wave * 1024 + it * 64 + F.lane;
        const float li = gates[(size_t)t * 8 + hh] + big; float v = logsigmoid_(gates[(size_t)t * 8 + 4 + hh] + bfg);
#pragma unroll
        for (int d = 1; d < 64; d <<= 1) { const float o = __shfl_up(v, d); if (F.lane >= d) v += o; }
        const float Bl = cB + v; const float wl = li - Bl; float mx = wl;
#pragma unroll
        for (int d = 1; d < 64; d <<= 1) { const float o = __shfl_up(mx, d); if (F.lane >= d) mx = fmaxf(mx, o); }
        mx = fmaxf(mx, cM);
        sB[t] = Bl; sW[t] = wl; sM[t] = mx;
        cB = __shfl(Bl, 63); cM = __shfl(mx, 63); }
    if (F.lane == 0) { tot[F.wave] = cB; tot[8 + F.wave] = cM; }
    __syncthreads();
    float Boff = 0.f, Min = 0.f;
    for (int w = 0; w < F.wave; ++w) { Min = fmaxf(Min, tot[8 + w] - Boff); Boff += tot[w]; }
    float* BC = (float*)(F.ws + WS_BC) + hh * SP; float* BW = (float*)(F.ws + WS_BW) + hh * SP; float* MR = (float*)(F.ws + WS_MR) + hh * SP;
    for (int it = 0; it < 16; ++it) { const int t = F.wave * 1024 + it * 64 + F.lane;
        const float B = Boff + sB[t], W = sW[t] - Boff, M = fmaxf(Min, sM[t] - Boff);
        BC[t] = B; BW[t] = W; MR[t] = M;
        if (t == SP - 1) F.out[O_MP + hh] = B + M; }
    __syncthreads();
}

__device__ __forceinline__ void attn_prompt_unit(const Frame& F, int qb, int g) {
    const bf16_t* P = (const bf16_t*)(F.ws + WS_P); const float* rope = (const float*)(F.ws + WS_ROPE);
    bf16_t* MIX = (bf16_t*)(F.ws + WS_MIX);
    LAS bf16_t* Ks = (LAS bf16_t*)F.lds;
    LAS bf16_t* Vt = Ks + 192 * 72;
    LAS bf16_t* Pw = Vt + 64 * 200 + F.wave * (16 * 200);
    const int q0 = qb * 64, lane = F.lane, fr = lane & 15, kg = lane >> 4, dgs = F.tid & 7;
    const int hq = g * 4 + (F.wave & 3), qh = F.wave >> 2;
    u32x4 qn0, qn1, qno; f32x4 qnc[4];
#define ATT_QLOAD(qtx) do { const int trx = q0 + qh * 32 + (qtx) * 16 + fr; const bf16_t* rowx = P + (size_t)trx * NIN + C_AQ + hq * 64; qn0 = *(const u32x4*)(rowx + kg * 8); qn1 = *(const u32x4*)(rowx + 32 + kg * 8); \
        if (kg < 2) { qno = *(const u32x4*)(rowx + (kg ^ 1) * 8); _Pragma("unroll") for (int k = 0; k < 4; ++k) qnc[k] = *(const f32x4*)(rope + (size_t)trx * 16 + 4 * k); } } while (0)
    ATT_QLOAD(0);
    u32x4 kv[3], ov[3], vv[2][2]; f32x4 kc[3][4];
#pragma unroll
    for (int it = 0; it < 3; ++it) { const int key = (it * 512 + F.tid) >> 3, kp = q0 - 128 + key; kv[it] = *(const u32x4*)(P + (size_t)(kp < 0 ? 0 : kp) * NIN + C_AK + g * 64 + dgs * 8); }
    if (dgs < 2) {
#pragma unroll
        for (int it = 0; it < 3; ++it) { const int key = (it * 512 + F.tid) >> 3, kp = q0 - 128 + key, kpc = kp < 0 ? 0 : kp; ov[it] = *(const u32x4*)(P + (size_t)kpc * NIN + C_AK + g * 64 + (dgs ^ 1) * 8);
#pragma unroll
            for (int k = 0; k < 4; ++k) kc[it][k] = *(const f32x4*)(rope + (size_t)kpc * 16 + 4 * k); } }
#pragma unroll
    for (int it = 0; it < 2; ++it) { const int item = it * 512 + F.tid; const int k2 = item < 768 ? item % 96 : 0, dg = item < 768 ? item / 96 : 0, kp = q0 - 128 + 2 * k2;
        const bf16_t* row = P + (size_t)(kp < 0 ? 0 : kp) * NIN + C_AV + g * 64 + dg * 8; vv[it][0] = *(const u32x4*)row; vv[it][1] = *(const u32x4*)(row + NIN); }
#pragma unroll
    for (int it = 0; it < 3; ++it) { const int key = (it * 512 + F.tid) >> 3, kp = q0 - 128 + key; u32x4 k4 = kv[it];
        if (dgs < 2) { float a[8], b[8]; unpack8(k4, a); unpack8(ov[it], b);
#pragma unroll
            for (int i = 0; i < 8; ++i) { const float cs = kc[it][i >> 2][i & 3], sn = kc[it][2 + (i >> 2)][i & 3]; a[i] = (dgs == 0) ? a[i] * cs - b[i] * sn : a[i] * cs + b[i] * sn; }
            k4 = pack8(a); }
        if (kp < 0) k4 = (u32x4){0u, 0u, 0u, 0u};
        *(LAS u32x4*)(Ks + key * 72 + dgs * 8) = k4; }
#pragma unroll
    for (int it = 0; it < 2; ++it) { const int item = it * 512 + F.tid; if (item < 768) { const int k2 = item % 96, dg = item / 96, kp = q0 - 128 + 2 * k2;
        u32x4 v0 = vv[it][0], v1 = vv[it][1]; if (kp < 0) { v0 = (u32x4){0u, 0u, 0u, 0u}; v1 = v0; }
        unsigned w[8]; zip8(v0, v1, w);
#pragma unroll
        for (int i = 0; i < 8; ++i) *(LAS unsigned*)(Vt + (dg * 8 + i) * 200 + 2 * k2) = w[i]; } }
    __syncthreads();
    const float sink = F.in[17][hq];
    for (int qt = 0; qt < 2; ++qt) {
        const int tq = q0 + qh * 32 + qt * 16;
        bf16x8 qf[2];
        { u32x4 qv = qn0;
          if (kg < 2) { float a[8], b[8]; unpack8(qv, a); unpack8(qno, b);
#pragma unroll
              for (int i = 0; i < 8; ++i) { const float cs = qnc[i >> 2][i & 3], sn = qnc[2 + (i >> 2)][i & 3]; a[i] = (kg == 0) ? a[i] * cs - b[i] * sn : a[i] * cs + b[i] * sn; }
              qv = pack8(a); }
          qf[0] = __builtin_bit_cast(bf16x8, qv); qf[1] = __builtin_bit_cast(bf16x8, qn1); }
        if (qt == 0) ATT_QLOAD(1);
        f32x4 s[12];
#pragma unroll
        for (int kt = 0; kt < 12; ++kt) { s[kt] = (f32x4){0.f, 0.f, 0.f, 0.f};
#pragma unroll
            for (int ks = 0; ks < 2; ++ks) { const bf16x8 kf = *(const LAS bf16x8*)(Ks + (kt * 16 + fr) * 72 + ks * 32 + kg * 8);
                s[kt] = __builtin_amdgcn_mfma_f32_16x16x32_bf16(kf, qf[ks], s[kt], 0, 0, 0); } }
        const int qp = tq + fr; float m = sink;
#pragma unroll
        for (int kt = 0; kt < 12; ++kt)
#pragma unroll
            for (int j = 0; j < 4; ++j) { const int kp = q0 - 128 + kt * 16 + kg * 4 + j; const bool ok = (kp >= 0) && (kp <= qp) && (qp - kp < 128);
                const float v = ok ? s[kt][j] * 0.125f : -INFINITY; s[kt][j] = v; m = fmaxf(m, v); }
        m = fmaxf(m, __shfl_xor(m, 16)); m = fmaxf(m, __shfl_xor(m, 32));
        float sum = 0.f;
        asm volatile("" ::: "memory");
#pragma unroll
        for (int kt = 0; kt < 12; ++kt) {
#pragma unroll
            for (int j = 0; j < 4; ++j) { const float p = __expf(s[kt][j] - m); s[kt][j] = p; sum += p; }
            u32x2 pk; pk.x = cvt_pk_bf16(s[kt][0], s[kt][1]); pk.y = cvt_pk_bf16(s[kt][2], s[kt][3]);
            *(LAS u32x2*)(Pw + fr * 200 + kt * 16 + kg * 4) = pk; }
        asm volatile("" ::: "memory");
        sum += __shfl_xor(sum, 16); sum += __shfl_xor(sum, 32);
        const float linv = 1.f / (sum + __expf(sink - m));
        f32x4 o[4];
#pragma unroll
        for (int dt = 0; dt < 4; ++dt) o[dt] = (f32x4){0.f, 0.f, 0.f, 0.f};
#pragma unroll
        for (int kk = 0; kk < 6; ++kk) { const bf16x8 pf = *(const LAS bf16x8*)(Pw + fr * 200 + kk * 32 + kg * 8);
#pragma unroll
            for (int dt = 0; dt < 4; ++dt) { const bf16x8 vf = *(const LAS bf16x8*)(Vt + (dt * 16 + fr) * 200 + kk * 32 + kg * 8);
                o[dt] = __builtin_amdgcn_mfma_f32_16x16x32_bf16(vf, pf, o[dt], 0, 0, 0); } }
        { bf16_t* op = MIX + (size_t)(tq + fr) * D + hq * 64 + kg * 4;
#pragma unroll
          for (int dt = 0; dt < 4; ++dt) { u32x2 pk; pk.x = cvt_pk_bf16(o[dt][0] * linv, o[dt][1] * linv); pk.y = cvt_pk_bf16(o[dt][2] * linv, o[dt][3] * linv); *(u32x2*)(op + dt * 16) = pk; } }
    }
    __syncthreads();
}

#undef ATT_QLOAD
__device__ __forceinline__ void attn_sample_wave(const Frame& F, int unit) {
    const bf16_t* P = (const bf16_t*)(F.ws + WS_P); const float* rope = (const float*)(F.ws + WS_ROPE);
    bf16_t* MIX = (bf16_t*)(F.ws + WS_MIX);
    const int b = unit >> 4, hq = unit & 15, g = hq >> 2, lane = F.lane;
    LAS float* base = (LAS float*)F.lds + F.wave * 1408;
    LAS float* sq = base; LAS float* sk = base + 256; LAS float* sv = base + 512; LAS float* sp = base + 768;
    float q4[4], k4[4], v4[4], qo4[4], ko4[4], c4[4], s4[4];
#pragma unroll
    for (int t = 0; t < 4; ++t) { const bf16_t* row = P + (size_t)(SP + b * 4 + t) * NIN; const float* cs = rope + (size_t)(SP + t) * 16;
        q4[t] = bf2f(row[C_AQ + hq * 64 + lane]); k4[t] = bf2f(row[C_AK + g * 64 + lane]); v4[t] = bf2f(row[C_AV + g * 64 + lane]);
        qo4[t] = bf2f(row[C_AQ + hq * 64 + ((lane ^ 8) & 15)]); ko4[t] = bf2f(row[C_AK + g * 64 + ((lane ^ 8) & 15)]); c4[t] = cs[lane & 7]; s4[t] = cs[8 + (lane & 7)]; }
#pragma unroll
    for (int t = 0; t < 4; ++t) { float qv = q4[t], kv = k4[t]; const float vv = v4[t];
        if (lane < 16) { const float c = c4[t], sn = s4[t]; if (lane < 8) { qv = qv * c - qo4[t] * sn; kv = kv * c - ko4[t] * sn; } else { qv = qv * c + qo4[t] * sn; kv = kv * c + ko4[t] * sn; } }
        sq[t * 64 + lane] = qv * 0.125f; sk[t * 64 + lane] = kv; sv[t * 64 + lane] = vv;
        if ((hq & 3) == 0) { F.out[O_KWS + ((size_t)b * 128 + 124 + t) * 256 + g * 64 + lane] = kv; F.out[O_VWS + ((size_t)b * 128 + 124 + t) * 256 + g * 64 + lane] = vv; } }
    const float sink = F.in[17][hq];
    float sc[3][4];
#pragma unroll
    for (int kk = 0; kk < 3; ++kk) { const int kidx = kk * 64 + lane;
#pragma unroll
        for (int t = 0; t < 4; ++t) sc[kk][t] = 0.f;
        if (kidx < 128) { const f32x4* kr = (const f32x4*)(F.in[2] + ((size_t)b * 128 + kidx) * 256 + g * 64);
#pragma unroll 8
            for (int d4 = 0; d4 < 16; ++d4) { const f32x4 kv = kr[d4];
#pragma unroll
                for (int t = 0; t < 4; ++t) { const f32x4 q = *(const LAS f32x4*)(sq + t * 64 + d4 * 4); sc[kk][t] += kv[0] * q[0] + kv[1] * q[1] + kv[2] * q[2] + kv[3] * q[3]; } } }
        else if (kidx < 132) { const int tn = kidx - 128;
#pragma unroll 4
            for (int d = 0; d < 64; ++d) { const float kv = sk[tn * 64 + d];
#pragma unroll
                for (int t = 0; t < 4; ++t) sc[kk][t] += kv * sq[t * 64 + d]; } }
#pragma unroll
        for (int t = 0; t < 4; ++t) { const bool ok = (kidx < 132) && (kidx > t) && (kidx <= t + 128); if (!ok) sc[kk][t] = -INFINITY; } }
    float linv[4];
#pragma unroll
    for (int t = 0; t < 4; ++t) { float m = fmaxf(fmaxf(sc[0][t], sc[1][t]), sc[2][t]); m = fmaxf(wave_max(m), sink);
        float sum = 0.f;
#pragma unroll
        for (int kk = 0; kk < 3; ++kk) { const float p = __expf(sc[kk][t] - m); sum += p; const int kidx = kk * 64 + lane; if (kidx < 160) sp[t * 160 + kidx] = p; }
        sum = wave_sum(sum) + __expf(sink - m); linv[t] = 1.f / sum; }
    const int kq = lane >> 4, dq = lane & 15;
    f32x4 o[4];
#pragma unroll
    for (int t = 0; t < 4; ++t) o[t] = (f32x4){0.f, 0.f, 0.f, 0.f};
    const float* vb = F.in[3] + ((size_t)b * 128 + kq) * 256 + g * 64 + dq * 4;
#pragma unroll 8
    for (int kb = 0; kb < 32; ++kb) { const f32x4 vv = *(const f32x4*)(vb + (size_t)kb * 1024);
#pragma unroll
        for (int t = 0; t < 4; ++t) o[t] += vv * sp[t * 160 + kb * 4 + kq]; }
    { const f32x4 vv = *(const LAS f32x4*)(sv + kq * 64 + dq * 4);
#pragma unroll
      for (int t = 0; t < 4; ++t) o[t] += vv * sp[t * 160 + 128 + kq]; }
#pragma unroll
    for (int t = 0; t < 4; ++t) {
#pragma unroll
        for (int e = 0; e < 4; ++e) { float v = o[t][e]; v += __shfl_xor(v, 16); v += __shfl_xor(v, 32); o[t][e] = v * linv[t]; }
        if (kq == t) { u32x2 pk; pk.x = cvt_pk_bf16(o[t][0], o[t][1]); pk.y = cvt_pk_bf16(o[t][2], o[t][3]); *(u32x2*)(MIX + (size_t)(SP + b * 4 + t) * D + hq * 64 + dq * 4) = pk; } }
}

__device__ __forceinline__ void mlstm_sample_unit(const Frame& F, int b, int h) {
    const bf16_t* P = (const bf16_t*)(F.ws + WS_P); const float* gates = (const float*)(F.ws + WS_GATES);
    bf16_t* MIX = (bf16_t*)(F.ws + WS_MIX);
    LAS float* sq = (LAS float*)F.lds; LAS float* sk = sq + 1024; LAS float* sv = sk + 1024; LAS float* sS = sv + 1024;
    const int tid = F.tid, lane = F.lane;
    const int bh = b * 4 + h;
    for (int i = tid; i < 1024; i += 512) { const int t = i >> 8, d = i & 255; const bf16_t* row = P + (size_t)(SP + b * 4 + t) * NIN;
        sq[i] = bf2f(row[C_MQ + h * 256 + d]) * 0.0625f; sk[i] = bf2f(row[C_MK + h * 256 + d]); sv[i] = bf2f(row[C_MV + h * 256 + d]); }
    if (tid < 64) sS[tid] = 0.f;
    __syncthreads();
    {
        const int pair = tid >> 5, sub = tid & 31, t = pair >> 2, s = pair & 3; float a = 0.f, c = 0.f;
#pragma unroll
        for (int e = 0; e < 8; ++e) { const int d = sub * 8 + e; a += sq[t * 256 + d] * sk[s * 256 + d]; if (s == 0) c += sq[t * 256 + d] * F.in[5][(size_t)bh * 256 + d]; }
#pragma unroll
        for (int o = 16; o >= 1; o >>= 1) { a += __shfl_xor(a, o); c += __shfl_xor(c, o); }
        if (sub == 0) { sS[pair] = a; if (s == 0) sS[16 + t] = c; } }
    __syncthreads();
    float li[4], bcum[4], mt[4], at[4], gs[4], sm[4][4], den[4];
    const float m0 = F.in[6][bh];
    { float acc = 0.f;
#pragma unroll
      for (int t = 0; t < 4; ++t) { const float* gp = gates + (size_t)(SP + b * 4 + t) * 8; li[t] = gp[h] + F.in[15][h]; acc += logsigmoid_fast(gp[4 + h] + F.in[16][h]); bcum[t] = acc; } }
#pragma unroll
    for (int t = 0; t < 4; ++t) { const float mi = bcum[t] + m0; float m = mi;
#pragma unroll
        for (int s = 0; s < 4; ++s) if (s <= t) m = fmaxf(m, bcum[t] - bcum[s] + li[s]);
        mt[t] = m; at[t] = __expf(mi - m); float dsum = at[t] * sS[16 + t];
#pragma unroll
        for (int s = 0; s < 4; ++s) { sm[t][s] = (s <= t) ? sS[t * 4 + s] * __expf(bcum[t] - bcum[s] + li[s] - m) : 0.f; dsum += sm[t][s]; }
        den[t] = fmaxf(fabsf(dsum), __expf(-m)); }
    const float mnew = mt[3], decay = __expf(bcum[3] + m0 - mnew);
#pragma unroll
    for (int s = 0; s < 4; ++s) gs[s] = __expf(bcum[3] - bcum[s] + li[s] - mnew);
    const int r8 = lane >> 3, seg = lane & 7, w = F.wave;
    const float* c0b = F.in[4] + (size_t)bh * 65536 + (size_t)(w * 32 + r8) * 256 + seg * 4;
    float* c1b = F.out + O_CS + (size_t)bh * 65536 + (size_t)(w * 32 + r8) * 256 + seg * 4;
    float acc[4][4], gv[4][4];
#pragma unroll
    for (int rg = 0; rg < 4; ++rg)
#pragma unroll
        for (int t = 0; t < 4; ++t) { acc[rg][t] = 0.f; gv[rg][t] = gs[t] * sv[t * 256 + w * 32 + rg * 8 + r8]; }
    if (tid == 0) {
#pragma unroll
        for (int t = 0; t < 4; ++t) { sS[40 + t] = at[t]; sS[44 + t] = den[t];
#pragma unroll
            for (int s2 = 0; s2 < 4; ++s2) sS[48 + t * 4 + s2] = sm[t][s2]; } }
    f32x4 c[2][2][4];
#pragma unroll
    for (int i2 = 0; i2 < 2; ++i2)
#pragma unroll
        for (int rg = 0; rg < 4; ++rg) c[0][i2][rg] = __builtin_nontemporal_load((const f32x4*)(c0b + rg * 2048 + i2 * 32));
#pragma unroll
    for (int hh = 0; hh < 4; ++hh) {
        if (hh < 3) {
#pragma unroll
            for (int i2 = 0; i2 < 2; ++i2)
#pragma unroll
                for (int rg = 0; rg < 4; ++rg) c[(hh + 1) & 1][i2][rg] = __builtin_nontemporal_load((const f32x4*)(c0b + rg * 2048 + ((hh + 1) * 2 + i2) * 32)); }
#pragma unroll
        for (int i2 = 0; i2 < 2; ++i2) { const int it = hh * 2 + i2; const int d = it * 32 + seg * 4;
            f32x4 q[4], k[4];
#pragma unroll
            for (int t = 0; t < 4; ++t) { q[t] = *(const LAS f32x4*)(sq + t * 256 + d); k[t] = *(const LAS f32x4*)(sk + t * 256 + d); }
#pragma unroll
            for (int rg = 0; rg < 4; ++rg) { const f32x4 cv = c[hh & 1][i2][rg]; f32x4 nv = cv * decay;
#pragma unroll
                for (int t = 0; t < 4; ++t) { acc[rg][t] += cv[0] * q[t][0] + cv[1] * q[t][1] + cv[2] * q[t][2] + cv[3] * q[t][3]; nv += k[t] * gv[rg][t]; }
                __builtin_nontemporal_store(nv, (f32x4*)(c1b + rg * 2048 + it * 32)); } }
    }
    __syncthreads();
    float hv[4][4], ssq[4] = {0.f, 0.f, 0.f, 0.f};
#pragma unroll
    for (int rg = 0; rg < 4; ++rg)
#pragma unroll
        for (int t = 0; t < 4; ++t) { float a = acc[rg][t]; a += __shfl_xor(a, 1); a += __shfl_xor(a, 2); a += __shfl_xor(a, 4);
            float num = sS[40 + t] * a;
#pragma unroll
            for (int s2 = 0; s2 < 4; ++s2) num += sS[48 + t * 4 + s2] * sv[s2 * 256 + w * 32 + rg * 8 + r8];
            hv[rg][t] = num / sS[44 + t]; if (seg == 0) ssq[t] += hv[rg][t] * hv[rg][t]; }
#pragma unroll
    for (int t = 0; t < 4; ++t) { ssq[t] = wave_sum(ssq[t]); }
    if (lane == 0) {
#pragma unroll
        for (int t = 0; t < 4; ++t) lds_add(&sS[32 + t], ssq[t]); }
    if (tid < 256) { float nn = decay * F.in[5][(size_t)bh * 256 + tid];
#pragma unroll
        for (int s2 = 0; s2 < 4; ++s2) nn += gs[s2] * sk[s2 * 256 + tid];
        F.out[O_NS + (size_t)bh * 256 + tid] = nn; }
    if (tid == 0) F.out[O_MS + bh] = mnew;
    __syncthreads();
#pragma unroll
    for (int rg = 0; rg < 4; ++rg)
#pragma unroll
        for (int t = 0; t < 4; ++t) if (seg == ((rg * 4 + t) & 7)) { const int vr = w * 32 + rg * 8 + r8; const size_t row = (size_t)(SP + b * 4 + t);
            const float rms = rsqrtf(sS[32 + t] * (1.f / 256.f) + EPS); const float og = sigmoidf_(bf2f(P[row * NIN + C_MO + h * 256 + vr]));
            MIX[row * D + 1024 + h * 256 + vr] = (bf16_t)(cvt_pk_bf16(hv[rg][t] * rms * F.in[18][h * 256 + vr] * og, 0.f) & 0xffff); }
    __syncthreads();
}

__device__ __forceinline__ void mlstm_u_unit(const Frame& F, int c, int h, int vh) {
    const bf16_t* P = (const bf16_t*)(F.ws + WS_P);
    const float* BW = (const float*)(F.ws + WS_BW) + h * SP; const float* MR = (const float*)(F.ws + WS_MR) + h * SP;
    LAS bf16_t* VtS = (LAS bf16_t*)F.lds;
    LAS bf16_t* KtS = VtS + 128 * 72;
    LAS float* gS = (LAS float*)(KtS + 256 * 72);
    const int lane = F.lane, fr = lane & 15, kg = lane >> 4, w = F.wave;
    const float mend = MR[c * LC + LC - 1];
    f32x4 acc[4][4];
#pragma unroll
    for (int a = 0; a < 4; ++a)
#pragma unroll
        for (int b = 0; b < 4; ++b) acc[a][b] = (f32x4){0.f, 0.f, 0.f, 0.f};
    float un = 0.f;
    u32x4 vr0, vr1, kr[2][2]; float bw0, bw1, bwg;
#define D1_LOAD(sbx) do { const int s0x = c * LC + (sbx) * 64; { const int s2 = F.tid & 31, vg = F.tid >> 5; bw0 = BW[s0x + 2 * s2]; bw1 = BW[s0x + 2 * s2 + 1]; bwg = BW[s0x + (F.tid & 63)]; \
            const bf16_t* src = P + (size_t)(s0x + 2 * s2) * NIN + C_MV + h * 256 + vh * 128 + vg * 8; vr0 = *(const u32x4*)src; vr1 = *(const u32x4*)(src + NIN); } \
        _Pragma("unroll") for (int it = 0; it < 2; ++it) { const int item = it * 512 + F.tid, s2 = item & 31, dg = item >> 5; const bf16_t* src = P + (size_t)(s0x + 2 * s2) * NIN + C_MK + h * 256 + dg * 8; \
            kr[it][0] = *(const u32x4*)src; kr[it][1] = *(const u32x4*)(src + NIN); } } while (0)
    D1_LOAD(0);
    for (int sb = 0; sb < LC / 64; ++sb) {
        if (F.tid < 64) gS[F.tid] = __expf(bwg - mend);
        { const int s2 = F.tid & 31, vg = F.tid >> 5; const float g0 = __expf(bw0 - mend), g1 = __expf(bw1 - mend);
            float f0[8], f1[8]; unpack8(vr0, f0); unpack8(vr1, f1);
#pragma unroll
            for (int i = 0; i < 8; ++i) *(LAS unsigned*)(VtS + (vg * 8 + i) * 72 + 2 * s2) = cvt_pk_bf16(f0[i] * g0, f1[i] * g1); }
#pragma unroll
        for (int it = 0; it < 2; ++it) { const int item = it * 512 + F.tid, s2 = item & 31, dg = item >> 5;
            unsigned wd[8]; zip8(kr[it][0], kr[it][1], wd);
#pragma unroll
            for (int i = 0; i < 8; ++i) *(LAS unsigned*)(KtS + (dg * 8 + i) * 72 + 2 * s2) = wd[i]; }
        if (sb + 1 < LC / 64) D1_LOAD(sb + 1);
        __syncthreads();
#pragma unroll
        for (int ks = 0; ks < 2; ++ks) { bf16x8 vf[4];
#pragma unroll
            for (int vt = 0; vt < 4; ++vt) vf[vt] = *(const LAS bf16x8*)(VtS + ((w & 1) * 64 + vt * 16 + fr) * 72 + ks * 32 + kg * 8);
#pragma unroll
            for (int dt = 0; dt < 4; ++dt) { const bf16x8 kf = *(const LAS bf16x8*)(KtS + ((w >> 1) * 64 + dt * 16 + fr) * 72 + ks * 32 + kg * 8);
#pragma unroll
                for (int vt = 0; vt < 4; ++vt) acc[dt][vt] = __builtin_amdgcn_mfma_f32_16x16x32_bf16(kf, vf[vt], acc[dt][vt], 0, 0, 0); } }
        if (vh == 0 && F.tid < 256) {
#pragma unroll
            for (int j8 = 0; j8 < 8; ++j8) { float kf[8]; unpack8(*(const LAS u32x4*)(KtS + F.tid * 72 + j8 * 8), kf); const f32x4 ga = *(const LAS f32x4*)(gS + j8 * 8), gb = *(const LAS f32x4*)(gS + j8 * 8 + 4);
                un += ga[0] * kf[0] + ga[1] * kf[1] + ga[2] * kf[2] + ga[3] * kf[3] + gb[0] * kf[4] + gb[1] * kf[5] + gb[2] * kf[6] + gb[3] * kf[7]; } }
        __syncthreads(); }
    float* U = (float*)(F.ws + WS_U) + ((size_t)(c * 4 + h) * 256) * 256;
#pragma unroll
    for (int dt = 0; dt < 4; ++dt)
#pragma unroll
        for (int vt = 0; vt < 4; ++vt) { const int v = vh * 128 + (w & 1) * 64 + vt * 16 + fr, d = (w >> 1) * 64 + dt * 16 + kg * 4; *(f32x4*)(U + (size_t)v * 256 + d) = acc[dt][vt]; }
    if (vh == 0 && F.tid < 256) ((float*)(F.ws + WS_UN))[(c * 4 + h) * 256 + F.tid] = un;
}

#undef D1_LOAD
__device__ __forceinline__ void mlstm_state_scan(const Frame& F) {
    const float* MRb = (const float*)(F.ws + WS_MR);
    const float* U = (const float*)(F.ws + WS_U); bf16_t* CST = (bf16_t*)(F.ws + WS_CST);
    LAS float* sdec = (LAS float*)F.lds;
    if (F.tid < 128) { const int h = F.tid >> 5, c = F.tid & 31; const float* MR = MRb + h * SP; sdec[F.tid] = expf((c == 0 ? 0.f : MR[c * LC - 1]) - MR[c * LC + LC - 1]); }
    __syncthreads();
    const int gt = F.bid * 512 + F.tid, GT = F.G * 512;
    typedef float f32x2 __attribute__((ext_vector_type(2)));
    for (int e2 = gt; e2 < 131072; e2 += GT) { const int h = e2 >> 15;
        f32x2 C = (f32x2){0.f, 0.f};
#pragma unroll 1
        for (int c0 = 0; c0 < NCH; c0 += 8) { f32x2 u[8];
#pragma unroll
            for (int k = 0; k < 8; ++k) u[k] = *(const f32x2*)(U + (size_t)(c0 + k) * 262144 + (size_t)e2 * 2);
#pragma unroll
            for (int k = 0; k < 8; ++k) { *(unsigned*)(CST + (size_t)(c0 + k) * 262144 + (size_t)e2 * 2) = cvt_pk_bf16(C[0], C[1]); C = C * sdec[h * 32 + c0 + k] + u[k]; } }
        *(f32x2*)(F.out + O_CP + (size_t)e2 * 2) = C; }
    for (int e = gt; e < 1024; e += GT) { const int h = e >> 8; const float* UN = (const float*)(F.ws + WS_UN); float* NST = (float*)(F.ws + WS_NST);
        float n = 0.f;
        for (int c = 0; c < NCH; ++c) { NST[c * 1024 + e] = n; n = n * sdec[h * 32 + c] + UN[c * 1024 + e]; }
        F.out[O_NP + e] = n; }
    __syncthreads();
}

__device__ __forceinline__ void mlstm_out_unit(const Frame& F, int c, int h, int tb) {
    const bf16_t* P = (const bf16_t*)(F.ws + WS_P); bf16_t* MIX = (bf16_t*)(F.ws + WS_MIX);
    const float* BC = (const float*)(F.ws + WS_BC) + h * SP; const float* BW = (const float*)(F.ws + WS_BW) + h * SP; const float* MR = (const float*)(F.ws + WS_MR) + h * SP;
    const bf16_t* CST = (const bf16_t*)(F.ws + WS_CST) + (size_t)(c * 4 + h) * 65536; const float* NST = (const float*)(F.ws + WS_NST) + (c * 4 + h) * 256;
    LAS bf16_t* Qs = (LAS bf16_t*)F.lds;
    LAS bf16_t* Ks = Qs + 64 * 264;
    LAS bf16_t* VtS = Ks + 64 * 264;
    LAS bf16_t* Ps = VtS + 256 * 72;
    LAS float* sA = (LAS float*)(Ps + 64 * 72);
    LAS float* sDen = sA + 64;
    LAS float* sMr = sDen + 64;
    LAS float* sSq = sMr + 64;
    const int tid = F.tid, lane = F.lane, fr = lane & 15, kg = lane >> 4, w = F.wave;
    const int t0 = c * LC + tb * 64;
    const float mstart = c == 0 ? 0.f : MR[c * LC - 1];
#pragma unroll
    for (int it = 0; it < 4; ++it) { const int item = it * 512 + tid, t = item >> 5, dg = item & 31;
        *(LAS u32x4*)(Qs + t * 264 + dg * 8) = *(const u32x4*)(P + (size_t)(t0 + t) * NIN + C_MQ + h * 256 + dg * 8); }
    u32x4 kreg[4], vreg[2][2];
#define P6_LOAD(sbx) do { const int s0x = c * LC + (sbx) * 64; _Pragma("unroll") for (int it = 0; it < 4; ++it) { const int item = it * 512 + tid, sx = item >> 5, dg = item & 31; \
            kreg[it] = *(const u32x4*)(P + (size_t)(s0x + sx) * NIN + C_MK + h * 256 + dg * 8); } \
        _Pragma("unroll") for (int it = 0; it < 2; ++it) { const int item = it * 512 + tid, s2 = item & 31, vg = item >> 5; const bf16_t* src = P + (size_t)(s0x + 2 * s2) * NIN + C_MV + h * 256 + vg * 8; \
            vreg[it][0] = *(const u32x4*)src; vreg[it][1] = *(const u32x4*)(src + NIN); } } while (0)
    P6_LOAD(0);
    if (tid < 64) { const float mr = MR[t0 + tid]; sMr[tid] = mr; sA[tid] = expf(mstart - mr) * 0.0625f; sSq[tid] = 0.f; }
    __syncthreads();
    {
        const int t = tid >> 3, sub = tid & 7; float a = 0.f; f32x4 nv[8];
#pragma unroll
        for (int e4 = 0; e4 < 8; ++e4) nv[e4] = *(const f32x4*)(NST + sub * 32 + e4 * 4);
#pragma unroll
        for (int e4 = 0; e4 < 8; ++e4) { const u32x2 qq = *(const LAS u32x2*)(Qs + t * 264 + sub * 32 + e4 * 4);
            a += bf_lo(qq.x) * nv[e4][0] + bf_hi(qq.x) * nv[e4][1] + bf_lo(qq.y) * nv[e4][2] + bf_hi(qq.y) * nv[e4][3]; }
        a += __shfl_xor(a, 1); a += __shfl_xor(a, 2); a += __shfl_xor(a, 4);
        if (sub == 0) sDen[t] = a * sA[t]; }
    f32x4 acc[4][2];
#pragma unroll
    for (int a = 0; a < 4; ++a) { acc[a][0] = (f32x4){0.f, 0.f, 0.f, 0.f}; acc[a][1] = acc[a][0]; }
    { bf16x8 cf[8][2];
#pragma unroll
      for (int ks = 0; ks < 8; ++ks)
#pragma unroll
          for (int vt = 0; vt < 2; ++vt) cf[ks][vt] = __builtin_bit_cast(bf16x8, *(const u32x4*)(CST + (size_t)(w * 32 + vt * 16 + fr) * 256 + ks * 32 + kg * 8));
#pragma unroll
      for (int ks = 0; ks < 8; ++ks)
#pragma unroll
          for (int tt = 0; tt < 4; ++tt) { const bf16x8 qf = *(const LAS bf16x8*)(Qs + (tt * 16 + fr) * 264 + ks * 32 + kg * 8);
#pragma unroll
              for (int vt = 0; vt < 2; ++vt) acc[tt][vt] = __builtin_amdgcn_mfma_f32_16x16x32_bf16(cf[ks][vt], qf, acc[tt][vt], 0, 0, 0); } }
#pragma unroll
    for (int tt = 0; tt < 4; ++tt) { const float a = sA[tt * 16 + fr]; acc[tt][0] *= a; acc[tt][1] *= a; }
    __syncthreads();
    for (int sb = 0; sb <= tb; ++sb) { const int s0 = c * LC + sb * 64;
#pragma unroll
        for (int it = 0; it < 4; ++it) { const int item = it * 512 + tid, sx = item >> 5, dg = item & 31; *(LAS u32x4*)(Ks + sx * 264 + dg * 8) = kreg[it]; }
#pragma unroll
        for (int it = 0; it < 2; ++it) { const int item = it * 512 + tid, s2 = item & 31, vg = item >> 5;
            unsigned wd[8]; zip8(vreg[it][0], vreg[it][1], wd);
#pragma unroll
            for (int i = 0; i < 8; ++i) *(LAS unsigned*)(VtS + (vg * 8 + i) * 72 + 2 * s2) = wd[i]; }
        if (sb < tb) P6_LOAD(sb + 1);
        __syncthreads();
        {
            const int tt = w >> 1; f32x4 sacc[2]; sacc[0] = (f32x4){0.f, 0.f, 0.f, 0.f}; sacc[1] = sacc[0];
#pragma unroll 2
            for (int ks = 0; ks < 8; ++ks) { const bf16x8 qf = *(const LAS bf16x8*)(Qs + (tt * 16 + fr) * 264 + ks * 32 + kg * 8);
#pragma unroll
                for (int x = 0; x < 2; ++x) { const bf16x8 kf = *(const LAS bf16x8*)(Ks + (((w & 1) * 2 + x) * 16 + fr) * 264 + ks * 32 + kg * 8);
                    sacc[x] = __builtin_amdgcn_mfma_f32_16x16x32_bf16(qf, kf, sacc[x], 0, 0, 0); } }
            float rs[4] = {0.f, 0.f, 0.f, 0.f};
#pragma unroll
            for (int x = 0; x < 2; ++x) { const int sl = ((w & 1) * 2 + x) * 16 + fr; const float ws = BW[s0 + sl];
#pragma unroll
                for (int j = 0; j < 4; ++j) { const int tl = tt * 16 + kg * 4 + j; const bool ok = (s0 + sl) <= (t0 + tl);
                    const float pv = ok ? sacc[x][j] * 0.0625f * expf(ws - sMr[tl]) : 0.f; rs[j] += pv;
                    Ps[tl * 72 + sl] = (bf16_t)(cvt_pk_bf16(pv, 0.f) & 0xffff); } }
#pragma unroll
            for (int j = 0; j < 4; ++j) { float r = rs[j]; r += __shfl_xor(r, 1); r += __shfl_xor(r, 2); r += __shfl_xor(r, 4); r += __shfl_xor(r, 8);
                if (fr == 0) lds_add(&sDen[tt * 16 + kg * 4 + j], r); } }
        __syncthreads();
#pragma unroll
        for (int ks = 0; ks < 2; ++ks) { bf16x8 vf[2];
#pragma unroll
            for (int vt = 0; vt < 2; ++vt) vf[vt] = *(const LAS bf16x8*)(VtS + (w * 32 + vt * 16 + fr) * 72 + ks * 32 + kg * 8);
#pragma unroll
            for (int tt = 0; tt < 4; ++tt) { const bf16x8 pf = *(const LAS bf16x8*)(Ps + (tt * 16 + fr) * 72 + ks * 32 + kg * 8);
#pragma unroll
                for (int vt = 0; vt < 2; ++vt) acc[tt][vt] = __builtin_amdgcn_mfma_f32_16x16x32_bf16(vf[vt], pf, acc[tt][vt], 0, 0, 0); } }
        __syncthreads(); }
#pragma unroll
    for (int tt = 0; tt < 4; ++tt) { const int tl = tt * 16 + fr; const float mt = BC[t0 + tl] + sMr[tl]; const float dn = 1.f / fmaxf(fabsf(sDen[tl]), expf(-mt));
        acc[tt][0] *= dn; acc[tt][1] *= dn; float q = 0.f;
#pragma unroll
        for (int j = 0; j < 4; ++j) q += acc[tt][0][j] * acc[tt][0][j] + acc[tt][1][j] * acc[tt][1][j];
        q += __shfl_xor(q, 16); q += __shfl_xor(q, 32);
        if (kg == 0) lds_add(&sSq[tl], q); }
    __syncthreads();
    {
        u32x2 ogp[4][2]; f32x4 nwv[2];
#pragma unroll
        for (int vt = 0; vt < 2; ++vt) nwv[vt] = *(const f32x4*)(F.in[18] + h * 256 + w * 32 + vt * 16 + kg * 4);
#pragma unroll
        for (int tt = 0; tt < 4; ++tt)
#pragma unroll
            for (int vt = 0; vt < 2; ++vt) ogp[tt][vt] = *(const u32x2*)(P + (size_t)(t0 + tt * 16 + fr) * NIN + C_MO + h * 256 + w * 32 + vt * 16 + kg * 4);
#pragma unroll
        for (int tt = 0; tt < 4; ++tt) { const int tl = tt * 16 + fr; const float rms = rsqrtf(sSq[tl] * (1.f / 256.f) + EPS); bf16_t* op = MIX + (size_t)(t0 + tl) * D + 1024 + h * 256 + w * 32 + kg * 4;
#pragma unroll
            for (int vt = 0; vt < 2; ++vt) { const u32x2 og = ogp[tt][vt]; const f32x4 a4 = acc[tt][vt] * rms * nwv[vt];
                u32x2 pk; pk.x = cvt_pk_bf16(a4[0] * sigmoidf_(bf_lo(og.x)), a4[1] * sigmoidf_(bf_hi(og.x))); pk.y = cvt_pk_bf16(a4[2] * sigmoidf_(bf_lo(og.y)), a4[3] * sigmoidf_(bf_hi(og.y)));
                *(u32x2*)(op + vt * 16) = pk; } } }
    __syncthreads();
}

#undef P6_LOAD
__device__ __forceinline__ void final_norm_phase(const Frame& F, int rlo) {
    const float* nw = F.in[11];
    for (int r = rlo + F.bid * 8 + F.wave; r < MTOT; r += F.G * 8) { f32x4* xr = (f32x4*)(F.out + (size_t)r * D);
        const f32x4* sr = r < SP ? xr : (const f32x4*)(F.ws + WS_X1) + (size_t)r * (D / 4);
        f32x4 xv[8]; float ss = 0.f;
#pragma unroll
        for (int i = 0; i < 8; ++i) xv[i] = sr[i * 64 + F.lane];
        if (r >= SP) { for (int z = 0; z < 11; ++z) { const f32x4* pp = (const f32x4*)(F.ws + WS_PART) + ((size_t)z * MS + (r - SP)) * (D / 4);
#pragma unroll
                for (int i = 0; i < 8; ++i) xv[i] += pp[i * 64 + F.lane]; } }
#pragma unroll
        for (int i = 0; i < 8; ++i) ss += xv[i][0] * xv[i][0] + xv[i][1] * xv[i][1] + xv[i][2] * xv[i][2] + xv[i][3] * xv[i][3];
        ss = wave_sum(ss); const float rstd = rsqrtf(ss * (1.f / D) + EPS);
#pragma unroll
        for (int i = 0; i < 8; ++i) { const f32x4 w = ((const f32x4*)nw)[i * 64 + F.lane]; xr[i * 64 + F.lane] = xv[i] * rstd * w; } }
}

__global__ void __launch_bounds__(512, 2) fwd_mega(Params prm) {
    extern __shared__ __attribute__((aligned(16))) unsigned char lds_raw[];
    cg::grid_group grid = cg::this_grid();
    Frame F;
    F.lds = (LAS unsigned char*)lds_raw; F.tid = threadIdx.x; F.lane = F.tid & 63; F.wave = __builtin_amdgcn_readfirstlane(F.tid >> 6); F.G = gridDim.x; F.bid = blockIdx.x;
#pragma unroll
    for (int i = 0; i < 23; ++i) F.in[i] = prm.in[i];
    F.out = prm.out; F.ws = prm.ws;
    unsigned char* ws = F.ws;
    const int lo = prm.ph_lo, hi = prm.ph_hi;
#ifndef PH_MASK
#define PH_MASK 0xfff
#endif
#define IN(k) (((PH_MASK >> (k)) & 1) && lo <= (k) && (k) < hi)
#define SEAM(k) do { if (IN(k) && IN((k) + 1)) { if ((k) == 0) grid.sync(); else xcd_barrier(xbar); } } while (0)
#ifndef REPMASK
#define REPMASK 0
#endif
#define REPS(k) for (int rep_ = 0; rep_ < 1 + ((REPMASK >> (k)) & 1); ++rep_, (((REPMASK >> (k)) & 1) && rep_ == 1 ? grid.sync() : (void)0))
    const float* mod = (const float*)(ws + WS_MOD);
    volatile LAS unsigned* xst = (volatile LAS unsigned*)(F.lds + LDS_BYTES - 16);
    if (F.tid == 0) { xst[0] = 0u; xst[1] = 0u; }
    __syncthreads();
    XcdBarrier xbar; xbar.bar = (unsigned*)(ws + WS_BAR); xbar.x = 0; xbar.st = xst;
    if (hi - lo > 1) xbar = xcd_barrier_post((unsigned*)(ws + WS_BAR), xst);

    if (IN(0)) REPS(0) p0_prologue(F);
    SEAM(0);
    if (IN(1)) { { const int cb = F.G > 96 ? 48 : 0;
          if (F.bid >= cb) convert_tiles(F, 2496, 4608, F.bid - cb, F.G - cb); }
        pg8::Gemm g{(const bf16_t*)(ws + WS_SILU), (const bf16_t*)(ws + WS_WADA), D, D}; pg8::SplitKOrder S{48, 1, F.G, F.bid, 32};
        pg8::EpiMod E{(float*)(ws + WS_MOD), F.in[13]}; pg8::gemm_phase(F.lds, g, S, E); }
    SEAM(1);
    if (IN(2)) REPS(2) norm_mod_phase<true>(F, F.in[0], F.in[1], F.in[9], 0, 2048, 0, nullptr);
    SEAM(2);
    if (IN(3)) REPS(3) {
        if (F.bid >= F.G - 4) mlstm_scan(F, F.bid - (F.G - 4));
        pg8::Gemm g{(const bf16_t*)(ws + WS_H), (const bf16_t*)(ws + WS_WIN), D, D}; pg8::StaticOrder S; S.init(MTOT, NIN, F.G, F.bid, D / 64);
        pg8::EpiBf16 E{(bf16_t*)(ws + WS_P), NIN}; pg8::gemm_phase(F.lds, g, S, E); }
    SEAM(3);
    if (IN(4)) REPS(4) {
        const bool cfirst = (F.bid & 1) != 0;
        if (cfirst && (prm.p4m & 2)) for (int u = F.bid; u < 512; u += F.G) mlstm_sample_unit(F, u >> 2, u & 3);
        if (prm.p4m & 1) for (int u = F.bid; u < 256; u += F.G) mlstm_u_unit(F, u >> 3, (u >> 1) & 3, u & 1);
        if (prm.p4m & 4) for (int u = F.bid; u < 512; u += F.G) attn_prompt_unit(F, u >> 2, u & 3);
        if (prm.p4m & 8) for (int rep = 0; rep < ((prm.p4m & 16) ? 2 : 1); ++rep) for (int u = F.bid * 8 + F.wave; u < 2048; u += F.G * 8) attn_sample_wave(F, u);
        if (!cfirst && (prm.p4m & 2)) for (int u = F.bid; u < 512; u += F.G) mlstm_sample_unit(F, u >> 2, u & 3);
        { const bf16_t* P = (const bf16_t*)(ws + WS_P); const float* rope = (const float*)(ws + WS_ROPE);
          for (int i = F.bid * 512 + F.tid; i < 32768; i += F.G * 512) { const int pos = SP - 128 + (i >> 8), cc = i & 255, d = cc & 63; const bf16_t* row = P + (size_t)pos * NIN;
              float kv = bf2f(row[C_AK + cc]);
              if (d < 16) { const float ko = bf2f(row[C_AK + (cc ^ 8)]); const float cs = rope[pos * 16 + (d & 7)], sn = rope[pos * 16 + 8 + (d & 7)]; kv = d < 8 ? kv * cs - ko * sn : kv * cs + ko * sn; }
              F.out[O_KWP + i] = kv; F.out[O_VWP + i] = bf2f(row[C_AV + cc]); } }
    }
    SEAM(4);
    if (IN(5)) REPS(5) mlstm_state_scan(F);
    SEAM(5);
    if (IN(6)) REPS(6) { for (int u = F.bid; u < 512; u += F.G) { const int tb = u < 256 ? 3 - (u >> 7) : ((u - 256) >> 7); const int ch = u & 127; mlstm_out_unit(F, ch >> 2, ch & 3, tb); } }
    SEAM(6);
    if (IN(7)) REPS(7) { pg8::Gemm g{(const bf16_t*)(ws + WS_MIX), (const bf16_t*)(ws + WS_WOUT), D, D}; pg8::PromptSampleOrder S{F.G, F.bid, D / 64, 4};
        pg8::EpiRes E{(float*)(ws + WS_X1), F.in[0], F.in[1], mod + 4096, (float*)(ws + WS_PART)}; pg8::gemm_phase(F.lds, g, S, E);
        if (F.G == 256) { if (F.bid >= 64) kvwin_copy(F, (F.bid - 64) * 512 + F.tid, (F.G - 64) * 512); } else kvwin_copy(F, F.bid * 512 + F.tid, F.G * 512); }
    SEAM(7);
    if (IN(8)) REPS(8) { float* x1 = (float*)(ws + WS_X1); norm_mod_phase<false>(F, x1, F.in[1], F.in[10], 3 * 2048, 4 * 2048, 4, x1 + (size_t)SP * D); }
    SEAM(8);
    if (IN(9)) REPS(9) { pg8::Gemm g{(const bf16_t*)(ws + WS_H), (const bf16_t*)(ws + WS_WGU), D, D}; pg8::StaticOrder S; S.init(MTOT, 2 * DFF, F.G, F.bid, D / 64);
        pg8::EpiGU E{(bf16_t*)(ws + WS_P), DFF}; pg8::gemm_phase(F.lds, g, S, E); }
    SEAM(9);
    if (IN(10)) REPS(10) { const float* x1 = (const float*)(ws + WS_X1); pg8::Gemm g{(const bf16_t*)(ws + WS_P), (const bf16_t*)(ws + WS_WDN), DFF, DFF}; pg8::PromptSampleOrder S{F.G, F.bid, DFF / 64, 11};
        if (F.G == 256) { pg8::EpiResNorm E{F.out + O_Y, x1, mod + 5 * 2048, (float*)(ws + WS_PART), F.in[11], (float*)(ws + WS_SSQ), (unsigned*)(ws + WS_PCNT), (LAS float*)(F.lds + 131072)}; pg8::gemm_phase(F.lds, g, S, E); }
        else { pg8::EpiRes E{F.out + O_Y, x1, x1 + (size_t)SP * D, mod + 5 * 2048, (float*)(ws + WS_PART)}; pg8::gemm_phase(F.lds, g, S, E); } }
    SEAM(10);
    if (IN(11)) final_norm_phase(F, F.G == 256 ? SP : 0);
#undef IN
#undef SEAM
}

#ifndef MK_MULTI
#define MK_MULTI 0
#endif

extern "C" void kernel_launch(void* const* d_in, const int* in_sizes, int n_in, void* d_out, int out_size, void* d_ws, size_t ws_size, hipStream_t stream) {
    static int grid = 0;
    if (grid == 0) {
        if (n_in != 23 || (size_t)out_size != O_END || ws_size < WS_END) { fprintf(stderr, "kernel_launch: unexpected sizes: n_in %d out %d (want %zu) ws %zu (want >= %zu)\n", n_in, out_size, (size_t)O_END, ws_size, (size_t)WS_END); grid = -1; return; }
        int dev = 0, cus = 0, per_cu = 0;
        (void)hipGetDevice(&dev); (void)hipDeviceGetAttribute(&cus, hipDeviceAttributeMultiprocessorCount, dev);
        if (hipFuncSetAttribute((const void*)fwd_mega, hipFuncAttributeMaxDynamicSharedMemorySize, LDS_BYTES) != hipSuccess) { fprintf(stderr, "kernel_launch: hipFuncSetAttribute failed\n"); grid = -1; return; }
        if (hipOccupancyMaxActiveBlocksPerMultiprocessor(&per_cu, (const void*)fwd_mega, 512, LDS_BYTES) != hipSuccess || per_cu < 1) { fprintf(stderr, "kernel_launch: occupancy query says %d blocks/CU\n", per_cu); per_cu = 1; }
        (void)hipGetLastError();
        grid = cus * 1;
        fprintf(stderr, "kernel_launch: cus %d per_cu %d grid %d ws %zu need %zu\n", cus, per_cu, grid, ws_size, (size_t)WS_END);
    }
    if (grid < 0) return;
    Params p{};
    for (int i = 0; i < 23; ++i) p.in[i] = (const float*)d_in[i];
    p.out = (float*)d_out; p.ws = (unsigned char*)d_ws; p.p4m = 15;
#if MK_MULTI
#ifndef DUPMASK
#define DUPMASK 0
#endif
#ifndef DUP_P4M
#define DUP_P4M 15
#endif
    for (int ph = 0; ph < NPHASE; ++ph) for (int r = 0; r < 1 + ((DUPMASK >> ph) & 1); ++r) { p.ph_lo = ph; p.ph_hi = ph + 1; p.p4m = (r == 1 && ph == 4) ? DUP_P4M : 15; hipLaunchKernelGGL(fwd_mega, dim3(grid), dim3(512), LDS_BYTES, stream, p); }
#else
    p.ph_lo = 0; p.ph_hi = NPHASE;
    (void)hipMemsetAsync((unsigned char*)d_ws + WS_BAR, 0, 16384, stream);
    void* args[] = {&p};
    hipError_t e = hipLaunchCooperativeKernel((const void*)fwd_mega, dim3(grid), dim3(512), args, LDS_BYTES, stream);
    if (e != hipSuccess) fprintf(stderr, "cooperative launch failed: %s (grid %d)\n", hipGetErrorString(e), grid);
#endif
}
```

```cpp
#include <hip/hip_runtime.h>
#include <hip/hip_cooperative_groups.h>
#include <cstdio>
#include <cstdint>
namespace cg = cooperative_groups;

#define LAS __attribute__((address_space(3)))
typedef unsigned short bf16_t;
typedef short bf16x8 __attribute__((ext_vector_type(8)));
typedef float f32x4 __attribute__((ext_vector_type(4)));
typedef unsigned u32x4 __attribute__((ext_vector_type(4)));
typedef unsigned u32x2 __attribute__((ext_vector_type(2)));

constexpr int D = 2048, SP = 8192, NB = 128, TS = 4, MS = NB * TS, MTOT = SP + MS;
constexpr int NIN = 5632, INW = 5640, DFF = 5632, NMOD = 12288;
constexpr int C_AQ = 0, C_AK = 1024, C_AV = 1280, C_MQ = 1536, C_MK = 2560, C_MV = 3584, C_MO = 4608;
constexpr float EPS = 1e-6f;
constexpr int LC = 256, NCH = SP / LC;

constexpr size_t al256(size_t x) { return (x + 255) & ~(size_t)255; }
constexpr size_t WS_WADA = 0;
constexpr size_t WS_WIN = WS_WADA + (size_t)NMOD * D * 2;
constexpr size_t WS_WOUT = WS_WIN + (size_t)NIN * D * 2;
constexpr size_t WS_WGU = WS_WOUT + (size_t)D * D * 2;
constexpr size_t WS_WDN = WS_WGU + (size_t)2 * DFF * D * 2;
constexpr size_t WS_SILU = WS_WDN + (size_t)D * DFF * 2;
constexpr size_t WS_MOD = WS_SILU + (size_t)256 * D * 2;
constexpr size_t WS_H = al256(WS_MOD + (size_t)129 * NMOD * 4);
constexpr size_t WS_GATES = WS_H + (size_t)MTOT * D * 2;
constexpr size_t WS_P = al256(WS_GATES + (size_t)MTOT * 8 * 4);
constexpr size_t WS_MIX = WS_P + (size_t)MTOT * NIN * 2;
constexpr size_t WS_X1 = WS_MIX + (size_t)MTOT * D * 2;
constexpr size_t WS_ROPE = WS_X1 + (size_t)MTOT * D * 4;
constexpr size_t WS_WG = al256(WS_ROPE + (size_t)8196 * 16 * 4);
constexpr size_t WS_BC = WS_WG + (size_t)8 * D * 4;
constexpr size_t WS_BW = WS_BC + (size_t)4 * SP * 4;
constexpr size_t WS_MR = WS_BW + (size_t)4 * SP * 4;
constexpr size_t WS_U = WS_MR + (size_t)4 * SP * 4;
constexpr size_t WS_UN = WS_U + (size_t)NCH * 4 * 65536 * 4;
constexpr size_t WS_CST = WS_UN + (size_t)NCH * 4 * 256 * 4;
constexpr size_t WS_NST = WS_CST + (size_t)NCH * 4 * 65536 * 2;
constexpr size_t WS_PART = WS_NST + (size_t)NCH * 4 * 256 * 4;
constexpr size_t WS_BAR = WS_PART + (size_t)11 * MS * D * 4;
constexpr size_t WS_SSQ = WS_BAR + 16384;
constexpr size_t WS_END = WS_SSQ + (size_t)256 * 256 * 4;
constexpr size_t WS_PCNT = WS_BAR + 14336;

constexpr size_t O_Y = 0;
constexpr size_t O_KWP = (size_t)MTOT * D;
constexpr size_t O_VWP = O_KWP + 32768;
constexpr size_t O_CP = O_VWP + 32768;
constexpr size_t O_NP = O_CP + 262144;
constexpr size_t O_MP = O_NP + 1024;
constexpr size_t O_KWS = O_MP + 4;
constexpr size_t O_VWS = O_KWS + (size_t)NB * 128 * 256;
constexpr size_t O_CS = O_VWS + (size_t)NB * 128 * 256;
constexpr size_t O_NS = O_CS + (size_t)NB * 4 * 65536;
constexpr size_t O_MS = O_NS + (size_t)NB * 4 * 256;
constexpr size_t O_END = O_MS + (size_t)NB * 4;

constexpr int LDS_BYTES = 147456;
constexpr int NPHASE = 12;

struct Params { const float* in[23]; float* out; unsigned char* ws; int ph_lo, ph_hi, p4m, pad; };

__device__ __forceinline__ unsigned cvt_pk_bf16(float lo, float hi) { unsigned r; asm volatile("v_cvt_pk_bf16_f32 %0, %1, %2" : "=v"(r) : "v"(lo), "v"(hi)); return r; }
__device__ __forceinline__ float bf_lo(unsigned u) { return __uint_as_float(u << 16); }
__device__ __forceinline__ float bf_hi(unsigned u) { return __uint_as_float(u & 0xffff0000u); }
__device__ __forceinline__ float bf2f(bf16_t h) { return __uint_as_float((unsigned)h << 16); }
__device__ __forceinline__ float wave_sum(float v) {
#pragma unroll
    for (int o = 32; o >= 1; o >>= 1) v += __shfl_xor(v, o);
    return v;
}
__device__ __forceinline__ float wave_max(float v) {
#pragma unroll
    for (int o = 32; o >= 1; o >>= 1) v = fmaxf(v, __shfl_xor(v, o));
    return v;
}
__device__ __forceinline__ void lds_add(LAS float* p, float v) { __hip_atomic_fetch_add(p, v, __ATOMIC_RELAXED, __HIP_MEMORY_SCOPE_WORKGROUP); }
__device__ __forceinline__ float sigmoidf_(float x) { return 1.f / (1.f + __expf(-x)); }
__device__ __forceinline__ float logsigmoid_(float x) { return fminf(x, 0.f) - log1pf(expf(-fabsf(x))); }
__device__ __forceinline__ float logsigmoid_fast(float x) { return fminf(x, 0.f) - __logf(1.f + __expf(-fabsf(x))); }
__device__ __forceinline__ void unpack8(const u32x4 v, float (&f)[8]) {
    f[0] = bf_lo(v.x); f[1] = bf_hi(v.x); f[2] = bf_lo(v.y); f[3] = bf_hi(v.y); f[4] = bf_lo(v.z); f[5] = bf_hi(v.z); f[6] = bf_lo(v.w); f[7] = bf_hi(v.w);
}
__device__ __forceinline__ u32x4 pack8(const float (&f)[8]) {
    u32x4 r; r.x = cvt_pk_bf16(f[0], f[1]); r.y = cvt_pk_bf16(f[2], f[3]); r.z = cvt_pk_bf16(f[4], f[5]); r.w = cvt_pk_bf16(f[6], f[7]); return r;
}
__device__ __forceinline__ void zip8(const u32x4 a, const u32x4 b, unsigned (&w)[8]) {
    w[0] = (a.x & 0xffffu) | (b.x << 16); w[1] = (a.x >> 16) | (b.x & 0xffff0000u); w[2] = (a.y & 0xffffu) | (b.y << 16); w[3] = (a.y >> 16) | (b.y & 0xffff0000u);
    w[4] = (a.z & 0xffffu) | (b.z << 16); w[5] = (a.z >> 16) | (b.z & 0xffff0000u); w[6] = (a.w & 0xffffu) | (b.w << 16); w[7] = (a.w >> 16) | (b.w & 0xffff0000u);
}
__device__ __forceinline__ void rope8(float (&own)[8], const float (&oth)[8], const float* cs, int dg) {
#pragma unroll
    for (int i = 0; i < 8; ++i) { const float c = cs[i], s = cs[8 + i]; own[i] = (dg == 0) ? own[i] * c - oth[i] * s : own[i] * c + oth[i] * s; }
}

#define XB_TMO      128
#define XB_XCNT(j)  (256  + 64 * (j))
#define XB_XSUB(j)  (1280 + 64 * (j))
#define XB_XGEN(j)  (2304 + 64 * (j))
#define XB_TOP      3328
#define XB_TOPGEN   3392
#define XCD_BAR_WORDS 3456
#define XB_SPIN_CAP (1u << 18)

__device__ __forceinline__ unsigned xb_ld(unsigned* p)              { return __hip_atomic_load(p, __ATOMIC_RELAXED, __HIP_MEMORY_SCOPE_AGENT); }
__device__ __forceinline__ unsigned xb_add(unsigned* p, unsigned v) { return __hip_atomic_fetch_add(p, v, __ATOMIC_RELAXED, __HIP_MEMORY_SCOPE_AGENT); }
__device__ __forceinline__ unsigned xb_xcc_id() { return (unsigned)__builtin_amdgcn_s_getreg((3 << 11) | 20) & 0xFu; }
#define XB_SPIN(cond, bar) do { unsigned _sp = 0; while (cond) { __builtin_amdgcn_s_sleep(1); \
    if ((++_sp & 255u) == 0u) { if (xb_ld(&(bar)[XB_TMO])) break; if (_sp > XB_SPIN_CAP) { (void)xb_add(&(bar)[XB_TMO], 1u); break; } } } } while (0)

struct XcdBarrier {
    unsigned* bar; unsigned x;
    volatile LAS unsigned* st;
};

__device__ __forceinline__ XcdBarrier xcd_barrier_post(unsigned* bar, volatile LAS unsigned* st) {
    XcdBarrier b; b.bar = bar; b.x = xb_xcc_id(); b.st = st;
    if (threadIdx.x == 0) (void)xb_add(&bar[XB_XCNT(b.x)], 1u);
    return b;
}
__device__ __forceinline__ void xcd_barrier_complete(unsigned* bar, unsigned x, unsigned& nloc, unsigned& nx) {
    const unsigned G = gridDim.x * gridDim.y * gridDim.z;
    unsigned sum, cnt, mine, sp = 0u;
    for (;;) {
        sum = 0u; cnt = 0u; mine = 0u;
#pragma unroll
        for (unsigned j = 0; j < 16; ++j) { const unsigned c = xb_ld(&bar[XB_XCNT(j)]); sum += c; cnt += (c > 0u) ? 1u : 0u; mine = (j == x) ? c : mine; }
        if (sum == G) break;
        __builtin_amdgcn_s_sleep(1);
        if ((++sp & 255u) == 0u) { if (xb_ld(&bar[XB_TMO])) break; if (sp > XB_SPIN_CAP) { (void)xb_add(&bar[XB_TMO], 1u); break; } }
    }
    nloc = mine > 0u ? mine : 1u; nx = cnt > 0u ? cnt : 1u;
}

__device__ __forceinline__ void xcd_barrier(const XcdBarrier& b) {
    asm volatile("s_waitcnt vmcnt(0)" ::: "memory");
    __syncthreads();
    if (threadIdx.x == 0) {
        unsigned* bar = b.bar;
        __builtin_amdgcn_s_waitcnt(0);
        unsigned nloc = b.st[0], nx = b.st[1];
        if (nloc == 0u) { xcd_barrier_complete(bar, b.x, nloc, nx); b.st[0] = nloc; b.st[1] = nx; }
        const unsigned old = xb_add(&bar[XB_XSUB(b.x)], 1u);
        const unsigned gen = old / nloc;
        if (old + 1u == (gen + 1u) * nloc) {
            __builtin_amdgcn_fence(__ATOMIC_RELEASE, "agent");
            asm volatile("s_waitcnt vmcnt(0)" ::: "memory");
            const unsigned og = xb_add(&bar[XB_TOP], 1u);
            const unsigned tg = og / nx;
            if (og + 1u == (tg + 1u) * nx) xb_add(&bar[XB_TOPGEN], 1u);
            else XB_SPIN(xb_ld(&bar[XB_TOPGEN]) == tg, bar);
            __builtin_amdgcn_fence(__ATOMIC_ACQUIRE, "agent");
            xb_add(&bar[XB_XGEN(b.x)], 1u);
            asm volatile("s_waitcnt vmcnt(0)" ::: "memory");
        } else {
            XB_SPIN(xb_ld(&bar[XB_XGEN(b.x)]) == gen, bar);
            __builtin_amdgcn_fence(__ATOMIC_ACQUIRE, "agent");
            asm volatile("s_waitcnt vmcnt(0)" ::: "memory");
        }
    }
    __syncthreads();
}


__device__ __forceinline__ void grid_bar(unsigned* ctr, unsigned target) {
    __syncthreads();
    if (threadIdx.x == 0) {
        __builtin_amdgcn_fence(__ATOMIC_RELEASE, "agent");
        __hip_atomic_fetch_add(ctr, 1u, __ATOMIC_RELAXED, __HIP_MEMORY_SCOPE_AGENT);
        while (__hip_atomic_load(ctr, __ATOMIC_RELAXED, __HIP_MEMORY_SCOPE_AGENT) < target) __builtin_amdgcn_s_sleep(2);
        __builtin_amdgcn_fence(__ATOMIC_ACQUIRE, "agent");
    }
    __syncthreads();
}

namespace pg8 {
constexpr int BM = 256, BK = 64, HALF = 128, HTB = HALF * BK * 2, STAGE_BYTES = 8 * HTB, NXCD = 8, WGM = 8;
__host__ __device__ __forceinline__ int lds_byte(int r, int c) { const int st = (r >> 4) * 2 + (c >> 5), rr = r & 15, cc = c & 31, ob = rr * 64 + cc * 2; return st * 1024 + (ob ^ (((ob >> 9) & 1) << 5)); }
__host__ __device__ __forceinline__ void stage_rc(int b, int& R, int& C) { const int st = b / 1024, sb = b % 1024, swz = sb ^ (((sb >> 9) & 1) << 5); R = (st >> 1) * 16 + swz / 64; C = (st & 1) * 32 + (swz % 64) / 2; }
__host__ __device__ __forceinline__ int perm32(int rho) { const int n = rho >> 4, i = rho & 15; return 8 * (i >> 2) + 4 * n + (i & 3); }
struct Unit { int pm, pn, kz, nt; };
struct Gemm { const bf16_t* A; const bf16_t* Bt; int lda, ldb; };
struct StaticOrder {
    int nM, nN, nwg, G, c, nt;
    __device__ void init(int M, int N, int G_, int c_, int nt_) { nM = M / BM; nN = N / BM; nwg = nM * nN; G = G_; c = c_; nt = nt_; }
    __device__ bool next(int i, Unit& u) const {
        const long L = (long)i * G + c; if (L >= nwg) return false;
        int wgid = (int)L; { const int q = nwg / NXCD, r = nwg % NXCD, xcd = wgid % NXCD, off = wgid / NXCD; wgid = (xcd < r ? xcd * (q + 1) : r * (q + 1) + (xcd - r) * q) + off; }
        const int nig = WGM * nN, gid = wgid / nig, fm = gid * WGM, gsz = (nM - fm) < WGM ? (nM - fm) : WGM;
        u.pm = fm + ((wgid % nig) % gsz); u.pn = (wgid % nig) / gsz; u.kz = 0; u.nt = nt; return true;
    }
};
struct SplitKOrder {
    int nN, nz, G, c, nt;
    __device__ bool next(int i, Unit& u) const { const int L = i * G + c; if (L >= nN * nz) return false; u.pm = 0; u.pn = L % nN; u.kz = L / nN; u.nt = nt; return true; }
};
struct PromptSampleOrder {
    int G, c, ntfull, nz;
    __device__ bool next(int i, Unit& u) const {
        const int L = i * G + c; if (L >= 256 + 16 * nz) return false;
        if (L < 256) { int wgid = L; { const int q = 256 / NXCD, xcd = wgid % NXCD, off = wgid / NXCD; wgid = xcd * q + off; }
            const int nig = WGM * 8, gid = wgid / nig, fm = gid * WGM; u.pm = fm + ((wgid % nig) % WGM); u.pn = (wgid % nig) / WGM; u.kz = 0; u.nt = ntfull; }
        else { const int idx = L - 256; u.pn = idx & 7; u.pm = 32 + ((idx >> 3) & 1); u.kz = idx >> 4; u.nt = ntfull / nz; }
        return true; }
};

template <class Epi, class Sched>
__device__ __forceinline__ void gemm_phase(LAS unsigned char* lds, const Gemm g, const Sched& S, const Epi& E) {
    const int tid = threadIdx.x, wid = __builtin_amdgcn_readfirstlane(tid >> 6), lane = tid & 63, wr = wid >> 2, wc = wid & 3, fr = lane & 15, fq = lane >> 4;
    unsigned voffA[2], voffB[2];
#pragma unroll
    for (int i = 0; i < 2; ++i) { int R, C; stage_rc(tid * 16 + i * 8192, R, C); const int Rb = Epi::PERM ? ((R & ~31) + perm32(R & 31)) : R;
        voffA[i] = (unsigned)(R * g.lda + C) * 2u; voffB[i] = (unsigned)(Rb * g.ldb + C) * 2u; }
    const size_t kstep = (size_t)(BK * 2);
    const size_t hstepA = (size_t)HALF * g.lda * 2, hstepB = (size_t)HALF * g.ldb * 2;
    const size_t tstepA = 2 * hstepA, tstepB = 2 * hstepB;
    const unsigned ldsw = (unsigned)wid * 1024u;
    const int aoff = lds_byte(wr * 64 + fr, fq * 8), boff = lds_byte(wc * 32 + fr, fq * 8);
#define PG8_SA(b, h) (((b) * 2 + (h)) * HTB)
#define PG8_SB(b, h) ((4 + (b) * 2 + (h)) * HTB)
#define PG8_STAGE(bufoff, gbase, voff) do { _Pragma("unroll") for (int _i = 0; _i < 2; ++_i) \
        __builtin_amdgcn_global_load_lds((const unsigned*)((const char*)(gbase) + (voff)[_i]), (LAS unsigned*)(lds + (bufoff) + ldsw + _i * 8192), 16, 0, 0); } while (0)
#define PG8_LDA(dst, b, h) do { _Pragma("unroll") for (int m = 0; m < 4; ++m) _Pragma("unroll") for (int k = 0; k < 2; ++k) dst[m][k] = *(const LAS bf16x8*)(lds + PG8_SA(b, h) + aoff + m * 2048 + k * 1024); } while (0)
#define PG8_LDB(dst, b, h) do { _Pragma("unroll") for (int n = 0; n < 2; ++n) _Pragma("unroll") for (int k = 0; k < 2; ++k) dst[n][k] = *(const LAS bf16x8*)(lds + PG8_SB(b, h) + boff + n * 2048 + k * 1024); } while (0)
#define PG8_MMA(ai, bj, At, Bt) do { __builtin_amdgcn_s_setprio(1); _Pragma("unroll") for (int m = 0; m < 4; ++m) _Pragma("unroll") for (int n = 0; n < 2; ++n) _Pragma("unroll") for (int k = 0; k < 2; ++k) \
        acc[ai][bj][m][n] = __builtin_amdgcn_mfma_f32_16x16x32_bf16(Bt[n][k], At[m][k], acc[ai][bj][m][n], 0, 0, 0); __builtin_amdgcn_s_setprio(0); } while (0)
#define PG8_WAIT_V(n) asm volatile("s_waitcnt vmcnt(" #n ")" ::: "memory")
#define PG8_WAIT_L(n) asm volatile("s_waitcnt lgkmcnt(" #n ")" ::: "memory")
#define PG8_BAR __builtin_amdgcn_s_barrier()
#define PG8_SCHED __builtin_amdgcn_sched_barrier(0)
    Unit cur, nxt; int ui = 0;
    if (!S.next(0, cur)) return;
    f32x4 acc[2][2][4][2];
#pragma unroll
    for (int a = 0; a < 2; ++a)
#pragma unroll
        for (int b = 0; b < 2; ++b)
#pragma unroll
            for (int m = 0; m < 4; ++m)
#pragma unroll
                for (int n = 0; n < 2; ++n) acc[a][b][m][n] = (f32x4){0.f, 0.f, 0.f, 0.f};
    bf16x8 At[4][2], B0[2][2], B1[2][2];
    const char* cA = (const char*)g.A + (size_t)cur.pm * tstepA + (size_t)cur.kz * cur.nt * (BK * 2); const char* cB = (const char*)g.Bt + (size_t)cur.pn * tstepB + (size_t)cur.kz * cur.nt * (BK * 2);
    PG8_STAGE(PG8_SB(0, 0), cB, voffB); PG8_STAGE(PG8_SB(0, 1), cB + hstepB, voffB); PG8_STAGE(PG8_SA(0, 0), cA, voffA); PG8_STAGE(PG8_SA(0, 1), cA + hstepA, voffA);
    if (wr == 1) PG8_BAR;
    PG8_WAIT_V(2); PG8_BAR;
    PG8_STAGE(PG8_SB(1, 0), cB + kstep, voffB); PG8_STAGE(PG8_SA(1, 0), cA + kstep, voffA); PG8_STAGE(PG8_SB(1, 1), cB + hstepB + kstep, voffB);
    PG8_WAIT_V(6); PG8_BAR;
    for (;;) {
        const bool has_next = S.next(ui + 1, nxt);
        const char* nA = has_next ? (const char*)g.A + (size_t)nxt.pm * tstepA + (size_t)nxt.kz * nxt.nt * (BK * 2) : cA; const char* nB = has_next ? (const char*)g.Bt + (size_t)nxt.pn * tstepB + (size_t)nxt.kz * nxt.nt * (BK * 2) : cB;
        const int nt = cur.nt;
        for (int t = 0; t < nt; t += 2) {
            const bool last = (t == nt - 2);
            const char* a1 = cA + (size_t)(t + 1) * kstep;
            const char* a2 = last ? nA : cA + (size_t)(t + 2) * kstep; const char* b2 = last ? nB : cB + (size_t)(t + 2) * kstep;
            const char* a3 = a2 + kstep; const char* b3 = b2 + kstep;
            PG8_LDB(B0, 0, 0); PG8_LDB(B1, 0, 1); PG8_SCHED; PG8_LDA(At, 0, 0); PG8_STAGE(PG8_SA(1, 1), a1 + hstepA, voffA);
            PG8_WAIT_V(8); PG8_WAIT_L(0); PG8_BAR; PG8_MMA(0, 0, At, B0); PG8_MMA(0, 1, At, B1); PG8_BAR; PG8_SCHED;
            PG8_LDA(At, 0, 1); PG8_STAGE(PG8_SB(0, 0), b2, voffB); PG8_STAGE(PG8_SB(0, 1), b2 + hstepB, voffB); PG8_STAGE(PG8_SA(0, 0), a2, voffA);
            PG8_WAIT_V(8); PG8_WAIT_L(0); PG8_BAR; PG8_MMA(1, 0, At, B0); PG8_MMA(1, 1, At, B1); PG8_BAR; PG8_SCHED;
            PG8_LDB(B0, 1, 0); PG8_LDB(B1, 1, 1); PG8_SCHED; PG8_LDA(At, 1, 0); PG8_STAGE(PG8_SA(0, 1), a2 + hstepA, voffA);
            PG8_WAIT_V(8); PG8_WAIT_L(0); PG8_BAR; PG8_MMA(0, 0, At, B0); PG8_MMA(0, 1, At, B1); PG8_BAR; PG8_SCHED;
            PG8_LDA(At, 1, 1); PG8_STAGE(PG8_SB(1, 0), b3, voffB); PG8_STAGE(PG8_SB(1, 1), b3 + hstepB, voffB); PG8_STAGE(PG8_SA(1, 0), a3, voffA);
            PG8_WAIT_V(8); PG8_WAIT_L(0); PG8_BAR; PG8_MMA(1, 0, At, B0); PG8_MMA(1, 1, At, B1); PG8_BAR; PG8_SCHED;
        }
        if (wr == 0) PG8_BAR;
        E(acc, cur, wr, wc, fr, fq);
        if (!has_next) break;
#pragma unroll
        for (int a = 0; a < 2; ++a)
#pragma unroll
            for (int b = 0; b < 2; ++b)
#pragma unroll
                for (int m = 0; m < 4; ++m)
#pragma unroll
                    for (int n = 0; n < 2; ++n) acc[a][b][m][n] = (f32x4){0.f, 0.f, 0.f, 0.f};
        cur = nxt; cA = nA; cB = nB; ++ui;
        if (wr == 1) PG8_BAR;
    }
    PG8_WAIT_V(0);
    PG8_BAR;
#undef PG8_SA
#undef PG8_SB
#undef PG8_STAGE
#undef PG8_LDA
#undef PG8_LDB
#undef PG8_MMA
#undef PG8_WAIT_V
#undef PG8_WAIT_L
#undef PG8_BAR
#undef PG8_SCHED
}

struct EpiMod {
    static constexpr bool PERM = false;
    float* mod; const float* bias;
    __device__ __forceinline__ void operator()(const f32x4 (&acc)[2][2][4][2], const Unit& u, int wr, int wc, int fr, int fq) const {
        const int col0 = u.pn * BM + wc * 32 + 4 * fq;
        f32x4 bv[2][2];
#pragma unroll
        for (int bj = 0; bj < 2; ++bj)
#pragma unroll
            for (int n = 0; n < 2; ++n) bv[bj][n] = *(const f32x4*)(bias + col0 + bj * HALF + n * 16);
#pragma unroll
        for (int ai = 0; ai < 2; ++ai)
#pragma unroll
            for (int m = 0; m < 4; ++m) { const int row = ai * HALF + wr * 64 + m * 16 + fr; if (row < 129) {
#pragma unroll
                for (int bj = 0; bj < 2; ++bj)
#pragma unroll
                    for (int n = 0; n < 2; ++n) { const int c = col0 + bj * HALF + n * 16; *(f32x4*)(mod + (size_t)row * NMOD + c) = acc[ai][bj][m][n] + bv[bj][n]; } } }
    }
};
struct EpiBf16 {
    static constexpr bool PERM = true;
    bf16_t* O; int ldc;
    __device__ __forceinline__ void operator()(const f32x4 (&acc)[2][2][4][2], const Unit& u, int wr, int wc, int fr, int fq) const {
        const int row0 = u.pm * BM + wr * 64 + fr, col0 = u.pn * BM + wc * 32 + 8 * fq;
#pragma unroll
        for (int ai = 0; ai < 2; ++ai)
#pragma unroll
            for (int m = 0; m < 4; ++m) { bf16_t* rowp = O + (size_t)(row0 + ai * HALF + m * 16) * ldc + col0;
#pragma unroll
                for (int bj = 0; bj < 2; ++bj) { const f32x4 v0 = acc[ai][bj][m][0], v1 = acc[ai][bj][m][1];
                    u32x4 w; w.x = cvt_pk_bf16(v0[0], v0[1]); w.y = cvt_pk_bf16(v0[2], v0[3]); w.z = cvt_pk_bf16(v1[0], v1[1]); w.w = cvt_pk_bf16(v1[2], v1[3]);
                    *(u32x4*)(rowp + bj * HALF) = w; } }
    }
};
struct EpiGU {
    static constexpr bool PERM = true;
    bf16_t* O; int ldc;
    __device__ __forceinline__ void operator()(const f32x4 (&acc)[2][2][4][2], const Unit& u, int wr, int wc, int fr, int fq) const {
        const int row0 = u.pm * BM + wr * 64 + fr, col0 = u.pn * HALF + wc * 32 + 8 * fq;
#pragma unroll
        for (int ai = 0; ai < 2; ++ai)
#pragma unroll
            for (int m = 0; m < 4; ++m) { bf16_t* rowp = O + (size_t)(row0 + ai * HALF + m * 16) * ldc + col0;
                float r[8];
#pragma unroll
                for (int n = 0; n < 2; ++n)
#pragma unroll
                    for (int e = 0; e < 4; ++e) { const float gt = acc[ai][0][m][n][e], up = acc[ai][1][m][n][e]; r[n * 4 + e] = gt * __builtin_amdgcn_rcpf(1.f + __expf(-gt)) * up; }
                *(u32x4*)rowp = pack8(r); }
    }
};
__device__ __forceinline__ void store_partials(const f32x4 (&acc)[2][2][4][2], const Unit& u, int row0, int col0, const float* gate, float* part) {
    int poff = (u.kz * MS + (row0 - SP)) * D + col0; asm volatile("" : "+v"(poff));
#pragma unroll
    for (int am = 0; am < 4; ++am) { f32x4 gv[2][2][2];
#pragma unroll
        for (int m2 = 0; m2 < 2; ++m2) { const int rr = row0 - SP + (am >> 1) * HALF + ((am & 1) * 2 + m2) * 16; const int go = (rr >> 2) * NMOD + col0;
#pragma unroll
            for (int bj = 0; bj < 2; ++bj)
#pragma unroll
                for (int n = 0; n < 2; ++n) gv[m2][bj][n] = *(const f32x4*)(gate + (go + bj * HALF + n * 16)); }
#pragma unroll
        for (int m2 = 0; m2 < 2; ++m2) { const int po = poff + ((am >> 1) * HALF + ((am & 1) * 2 + m2) * 16) * D;
#pragma unroll
            for (int bj = 0; bj < 2; ++bj)
#pragma unroll
                for (int n = 0; n < 2; ++n) *(f32x4*)(part + (po + bj * HALF + n * 16)) = gv[m2][bj][n] * acc[am >> 1][bj][(am & 1) * 2 + m2][n]; } }
}
struct EpiRes {
    static constexpr bool PERM = false;
    float* out; const float* res0; const float* res1; const float* gate; float* part;
    __device__ __forceinline__ void operator()(const f32x4 (&acc)[2][2][4][2], const Unit& u, int wr, int wc, int fr, int fq) const {
        const int row0 = u.pm * BM + wr * 64 + fr, col0 = u.pn * BM + wc * 32 + 4 * fq;
        if (u.pm >= 32) { store_partials(acc, u, row0, col0, gate, part); return; }
        f32x4 gv[2][2];
#pragma unroll
        for (int bj = 0; bj < 2; ++bj)
#pragma unroll
            for (int n = 0; n < 2; ++n) gv[bj][n] = *(const f32x4*)(gate + (size_t)128 * NMOD + col0 + bj * HALF + n * 16);
        int roff = row0 * D + col0; asm volatile("" : "+v"(roff));
#pragma unroll
        for (int am = 0; am < 4; ++am) { f32x4 rv[2][2][2];
#pragma unroll
            for (int m2 = 0; m2 < 2; ++m2)
#pragma unroll
                for (int bj = 0; bj < 2; ++bj)
#pragma unroll
                    for (int n = 0; n < 2; ++n) rv[m2][bj][n] = *(const f32x4*)(res0 + (roff + ((am >> 1) * HALF + ((am & 1) * 2 + m2) * 16) * D + bj * HALF + n * 16));
#pragma unroll
            for (int m2 = 0; m2 < 2; ++m2)
#pragma unroll
                for (int bj = 0; bj < 2; ++bj)
#pragma unroll
                    for (int n = 0; n < 2; ++n) *(f32x4*)(out + (roff + ((am >> 1) * HALF + ((am & 1) * 2 + m2) * 16) * D + bj * HALF + n * 16)) = rv[m2][bj][n] + gv[bj][n] * acc[am >> 1][bj][(am & 1) * 2 + m2][n]; }
    }
};
struct EpiResNorm {
    static constexpr bool PERM = false;
    float* out; const float* res0; const float* gate; float* part; const float* nw; float* ssq; unsigned* pcnt; LAS float* red;
    __device__ __forceinline__ void operator()(const f32x4 (&acc)[2][2][4][2], const Unit& u, int wr, int wc, int fr, int fq) const {
        const int row0 = u.pm * BM + wr * 64 + fr, col0 = u.pn * BM + wc * 32 + 4 * fq, tid = threadIdx.x;
        if (u.pm >= 32) { store_partials(acc, u, row0, col0, gate, part); return; }
        const float* gp = gate + (size_t)128 * NMOD;
        int roff = row0 * D + col0; asm volatile("" : "+v"(roff));
#pragma unroll
        for (int ai = 0; ai < 2; ++ai)
#pragma unroll
            for (int m = 0; m < 4; ++m) { const int ro = roff + (ai * HALF + m * 16) * D; float ps = 0.f;
#pragma unroll
                for (int bj = 0; bj < 2; ++bj)
#pragma unroll
                    for (int n = 0; n < 2; ++n) { const int o = bj * HALF + n * 16; const f32x4 rv = *(const f32x4*)(res0 + (ro + o)), gv = *(const f32x4*)(gp + (col0 + o));
                        const f32x4 v = rv + gv * acc[ai][bj][m][n]; ps += v[0] * v[0] + v[1] * v[1] + v[2] * v[2] + v[3] * v[3]; }
                ps += __shfl_xor(ps, 16); ps += __shfl_xor(ps, 32);
                if (fq == 0) red[(ai * HALF + wr * 64 + m * 16 + fr) * 4 + wc] = ps; }
        __syncthreads();
        if (tid < 256) { const f32x4 r4 = *(const LAS f32x4*)(red + tid * 4);
            __hip_atomic_store(ssq + (size_t)(u.pm * 8 + u.pn) * 256 + tid, r4[0] + r4[1] + r4[2] + r4[3], __ATOMIC_RELAXED, __HIP_MEMORY_SCOPE_AGENT); }
        asm volatile("s_waitcnt vmcnt(0)" ::: "memory");
        __syncthreads();
        if (tid == 0) { __hip_atomic_fetch_add(pcnt + u.pm, 1u, __ATOMIC_RELAXED, __HIP_MEMORY_SCOPE_AGENT); unsigned sp = 0;
            while (__hip_atomic_load(pcnt + u.pm, __ATOMIC_RELAXED, __HIP_MEMORY_SCOPE_AGENT) < 8u && ++sp < (1u << 22)) __builtin_amdgcn_s_sleep(1); }
        __syncthreads();
        if (tid < 256) { float tot = 0.f; const float* sp = ssq + (size_t)(u.pm * 8) * 256 + tid;
#pragma unroll 1
            for (int j = 0; j < 8; ++j) { tot += __hip_atomic_load(sp, __ATOMIC_RELAXED, __HIP_MEMORY_SCOPE_AGENT); sp += 256; }
            red[1024 + tid] = rsqrtf(tot * (1.f / D) + EPS); }
        __syncthreads();
        int woff = row0 * D + col0; asm volatile("" : "+v"(woff));
        f32x4 gw[2][2], ww[2][2];
#pragma unroll
        for (int bj = 0; bj < 2; ++bj)
#pragma unroll
            for (int n = 0; n < 2; ++n) { gw[bj][n] = *(const f32x4*)(gp + (col0 + bj * HALF + n * 16)); ww[bj][n] = *(const f32x4*)(nw + (col0 + bj * HALF + n * 16)); }
#pragma unroll
        for (int am = 0; am < 4; ++am) { f32x4 rv[2][2][2]; float rr[2];
#pragma unroll
            for (int m2 = 0; m2 < 2; ++m2) { rr[m2] = red[1024 + (am >> 1) * HALF + wr * 64 + ((am & 1) * 2 + m2) * 16 + fr];
#pragma unroll
                for (int bj = 0; bj < 2; ++bj)
#pragma unroll
                    for (int n = 0; n < 2; ++n) rv[m2][bj][n] = *(const f32x4*)(res0 + (woff + ((am >> 1) * HALF + ((am & 1) * 2 + m2) * 16) * D + bj * HALF + n * 16)); }
#pragma unroll
            for (int m2 = 0; m2 < 2; ++m2)
#pragma unroll
                for (int bj = 0; bj < 2; ++bj)
#pragma unroll
                    for (int n = 0; n < 2; ++n) *(f32x4*)(out + (woff + ((am >> 1) * HALF + ((am & 1) * 2 + m2) * 16) * D + bj * HALF + n * 16)) = (rv[m2][bj][n] + gw[bj][n] * acc[am >> 1][bj][(am & 1) * 2 + m2][n]) * rr[m2] * ww[bj][n]; }
    }
};
}

struct Frame {
    LAS unsigned char* lds;
    int tid, lane, wave, G, bid;
    const float* in[23];
    float* out; unsigned char* ws;
};

struct TileDesc { const float* src; bf16_t* dst; int ldn, K, k0, n0, kind; };
__device__ __forceinline__ TileDesc tile_desc(const Frame& F, int t) {
    unsigned char* ws = F.ws; TileDesc d; int NT, idx; d.kind = 0;
    if (t < 1536) { d.src = F.in[12]; d.ldn = NMOD; d.K = D; NT = 48; idx = t; d.dst = (bf16_t*)(ws + WS_WADA); }
    else if (t < 2240) { d.src = F.in[14]; d.ldn = INW; d.K = D; NT = 22; idx = t - 1536; d.dst = (bf16_t*)(ws + WS_WIN); }
    else if (t < 2496) { d.src = F.in[19]; d.ldn = D; d.K = D; NT = 8; idx = t - 2240; d.dst = (bf16_t*)(ws + WS_WOUT); }
    else if (t < 3200) { d.src = F.in[20]; d.ldn = DFF; d.K = D; NT = 22; idx = t - 2496; d.dst = (bf16_t*)(ws + WS_WGU); d.kind = 1; }
    else if (t < 3904) { d.src = F.in[21]; d.ldn = DFF; d.K = D; NT = 22; idx = t - 3200; d.dst = (bf16_t*)(ws + WS_WGU); d.kind = 2; }
    else { d.src = F.in[22]; d.ldn = D; d.K = DFF; NT = 8; idx = t - 3904; d.dst = (bf16_t*)(ws + WS_WDN); }
    d.n0 = (idx % NT) * 256; d.k0 = (idx / NT) * 64; return d;
}
__device__ __forceinline__ void convert_tiles(const Frame& F, int tlo, int thi, int wb, int nw) {
    LAS float* tile = (LAS float*)F.lds;
    int t = tlo + wb; if (t >= thi) return;
    TileDesc d = tile_desc(F, t);
    f32x4 v[8];
#pragma unroll
    for (int i = 0; i < 8; ++i) v[i] = __builtin_nontemporal_load((const f32x4*)(d.src + (size_t)(d.k0 + i * 8 + F.wave) * d.ldn + d.n0 + F.lane * 4));
    for (;;) {
#pragma unroll
        for (int i = 0; i < 8; ++i) { LAS float* tp = tile + (i * 8 + F.wave) * 257 + F.lane * 4; tp[0] = v[i][0]; tp[1] = v[i][1]; tp[2] = v[i][2]; tp[3] = v[i][3]; }
        __syncthreads();
        const int tn = t + nw; const bool more = tn < thi; TileDesc dn = d;
        if (more) { dn = tile_desc(F, tn);
#pragma unroll
            for (int i = 0; i < 8; ++i) v[i] = __builtin_nontemporal_load((const f32x4*)(dn.src + (size_t)(dn.k0 + i * 8 + F.wave) * dn.ldn + dn.n0 + F.lane * 4)); }
#pragma unroll
        for (int it = 0; it < 4; ++it) { const int item = it * 512 + F.tid, n = item >> 3, kg = item & 7;
            float f[8];
#pragma unroll
            for (int j = 0; j < 8; ++j) f[j] = tile[(kg * 8 + j) * 257 + n];
            const int nn = d.n0 + n; const int row = d.kind == 0 ? nn : (((nn >> 7) << 8) + (nn & 127) + (d.kind == 2 ? 128 : 0));
            *(u32x4*)(d.dst + (size_t)row * d.K + d.k0 + kg * 8) = pack8(f); }
        __syncthreads();
        if (!more) break;
        t = tn; d = dn;
    }
}

__device__ __forceinline__ void p0_prologue(const Frame& F) {
    unsigned char* ws = F.ws;
    convert_tiles(F, 0, 1536, F.bid, F.G);
    const int gt = F.bid * 512 + F.tid, GT = F.G * 512;
    { bf16_t* sc = (bf16_t*)(ws + WS_SILU);
      for (int i = gt; i < 256 * D / 2; i += GT) { const int r = (i * 2) >> 11, c = (i * 2) & 2047; float a = 0.f, b = 0.f;
          if (r < 128) { a = F.in[8][r * D + c]; b = F.in[8][r * D + c + 1]; } else if (r == 128) { a = F.in[7][c]; b = F.in[7][c + 1]; }
          a = a / (1.f + expf(-a)); b = b / (1.f + expf(-b));
          *(unsigned*)(sc + (size_t)i * 2) = cvt_pk_bf16(a, b); } }
    { float* rt = (float*)(ws + WS_ROPE);
      for (int i = gt; i < 8196 * 8; i += GT) { const int pi = i >> 3, f = i & 7; const int pos = pi < SP ? pi : 16384 + (pi - SP);
          const float inv = f == 0 ? 1.0f : f == 1 ? 0.1939227432012558f : f == 2 ? 0.03760603070259094f : f == 3 ? 0.007292664609849453f : f == 4 ? 0.0014142135623842478f : f == 5 ? 0.00027424818836152554f : f == 6 ? 5.318296098266728e-05f : 1.0313386155758053e-05f;
          const float ang = (float)pos * inv; const double a = (double)ang; const double k = rint(a * 0.15915494309189535); const float r = (float)(a - k * 6.283185307179586);
          rt[pi * 16 + f] = cosf(r); rt[pi * 16 + 8 + f] = sinf(r); } }
    { float* wg = (float*)(ws + WS_WG); for (int i = gt; i < 8 * D; i += GT) { const int j = i >> 11, c = i & 2047; wg[i] = F.in[14][(size_t)c * INW + NIN + j]; } }
}

__device__ __forceinline__ void kvwin_copy(const Frame& F, int gt, int GT) {
    const int per = 124 * 64;
    for (int i0 = gt; i0 < NB * per; i0 += 4 * GT) { f32x4 a[4], b[4]; size_t so[4], dof[4];
#pragma unroll
        for (int u = 0; u < 4; ++u) { const int i = i0 + u * GT; const int ii = i < NB * per ? i : 0; const int bb = ii / per, o = ii - bb * per; so[u] = (size_t)bb * 8192 + 256 + o; dof[u] = (size_t)bb * 8192 + o;
            a[u] = __builtin_nontemporal_load((const f32x4*)F.in[2] + so[u]); b[u] = __builtin_nontemporal_load((const f32x4*)F.in[3] + so[u]); }
#pragma unroll
        for (int u = 0; u < 4; ++u) { if (i0 + u * GT < NB * per) { __builtin_nontemporal_store(a[u], (f32x4*)(F.out + O_KWS) + dof[u]); __builtin_nontemporal_store(b[u], (f32x4*)(F.out + O_VWS) + dof[u]); } } }
}

template <bool GATES>
__device__ __forceinline__ void norm_mod_phase(const Frame& F, const float* src0, const float* src1, const float* nw, int sh_off, int sc_off, int nparts, float* x1out) {
    const float* mod = (const float*)(F.ws + WS_MOD);
    bf16_t* H = (bf16_t*)(F.ws + WS_H);
    LAS float* wg = (LAS float*)F.lds;
    if (GATES) { const f32x4* s = (const f32x4*)(F.ws + WS_WG); for (int i = F.tid; i < 8 * D / 4; i += 512) ((LAS f32x4*)wg)[i] = s[i]; __syncthreads(); }
    f32x4 av[8], shv[8];
    { const float* mr = mod + (size_t)128 * NMOD;
#pragma unroll
      for (int i = 0; i < 8; ++i) { const int c4 = i * 64 + F.lane; const f32x4 w = ((const f32x4*)nw)[c4], sc = ((const f32x4*)(mr + sc_off))[c4]; shv[i] = ((const f32x4*)(mr + sh_off))[c4]; av[i] = w * (sc + 1.f); } }
    for (int r = F.bid * 8 + F.wave; r < MTOT; r += F.G * 8) {
        const float* xr = r < SP ? src0 + (size_t)r * D : src1 + (size_t)(r - SP) * D;
        f32x4 xv[8]; float ss = 0.f;
#pragma unroll
        for (int i = 0; i < 8; ++i) xv[i] = ((const f32x4*)xr)[i * 64 + F.lane];
        if (r >= SP) { const float* mr = mod + (size_t)((r - SP) >> 2) * NMOD;
#pragma unroll
            for (int i = 0; i < 8; ++i) { const int c4 = i * 64 + F.lane; const f32x4 w = ((const f32x4*)nw)[c4], sc = ((const f32x4*)(mr + sc_off))[c4]; shv[i] = ((const f32x4*)(mr + sh_off))[c4]; av[i] = w * (sc + 1.f); }
            if (nparts > 0) {
                for (int z = 0; z < nparts; ++z) { const f32x4* pp = (const f32x4*)(F.ws + WS_PART) + ((size_t)z * MS + (r - SP)) * (D / 4);
#pragma unroll
                    for (int i = 0; i < 8; ++i) xv[i] += pp[i * 64 + F.lane]; }
#pragma unroll
                for (int i = 0; i < 8; ++i) ((f32x4*)(x1out + (size_t)(r - SP) * D))[i * 64 + F.lane] = xv[i]; } }
#pragma unroll
        for (int i = 0; i < 8; ++i) ss += xv[i][0] * xv[i][0] + xv[i][1] * xv[i][1] + xv[i][2] * xv[i][2] + xv[i][3] * xv[i][3];
        ss = wave_sum(ss);
        const float rstd = rsqrtf(ss * (1.f / D) + EPS);
        float g[8];
#pragma unroll
        for (int j = 0; j < 8; ++j) g[j] = 0.f;
#pragma unroll
        for (int i = 0; i < 8; ++i) { const int c4 = i * 64 + F.lane;
            f32x4 h;
#pragma unroll
            for (int e = 0; e < 4; ++e) h[e] = (xv[i][e] * rstd) * av[i][e] + shv[i][e];
            u32x2 pk; pk.x = cvt_pk_bf16(h[0], h[1]); pk.y = cvt_pk_bf16(h[2], h[3]);
            *(u32x2*)(H + (size_t)r * D + c4 * 4) = pk;
            if (GATES) {
#pragma unroll
                for (int j = 0; j < 8; ++j) { const f32x4 wv = ((const LAS f32x4*)(wg + j * D))[c4]; g[j] += h[0] * wv[0] + h[1] * wv[1] + h[2] * wv[2] + h[3] * wv[3]; } } }
        if (GATES) {
#pragma unroll
            for (int j = 0; j < 8; ++j) g[j] = wave_sum(g[j]);
            if (F.lane == 0) { float* gp = (float*)(F.ws + WS_GATES) + (size_t)r * 8;
                *(f32x4*)gp = (f32x4){g[0], g[1], g[2], g[3]}; *(f32x4*)(gp + 4) = (f32x4){g[4], g[5], g[6], g[7]}; } }
    }
    if (GATES) __syncthreads();
}

__device__ __forceinline__ void mlstm_scan(const Frame& F, int hh) {
    LAS float* sB = (LAS float*)F.lds;
    LAS float* sW = sB + SP;
    LAS float* sM = sW + SP;
    LAS float* tot = sM + SP;
    const float* gates = (const float*)(F.ws + WS_GATES);
    const float big = F.in[15][hh], bfg = F.in[16][hh];
    float cB = 0.f, cM = -INFINITY;
    for (int it = 0; it < 16; ++it) { const int t = F.wave * 1024 + it * 64 + F.lane;
        const float li = gates[(size_t)t * 8 + hh] + big; float v = logsigmoid_(gates[(size_t)t * 8 + 4 + hh] + bfg);
#pragma unroll
        for (int d = 1; d < 64; d <<= 1) { const float o = __shfl_up(v, d); if (F.lane >= d) v += o; }
        const float Bl = cB + v; const float wl = li - Bl; float mx = wl;
#pragma unroll
        for (int d = 1; d < 64; d <<= 1) { const float o = __shfl_up(mx, d); if (F.lane >= d) mx = fmaxf(mx, o); }
        mx = fmaxf(mx, cM);
        sB[t] = Bl; sW[t] = wl; sM[t] = mx;
        cB = __shfl(Bl, 63); cM = __shfl(mx, 63); }
    if (F.lane == 0) { tot[F.wave] = cB; tot[8 + F.wave] = cM; }
    __syncthreads();
    float Boff = 0.f, Min = 0.f;
    for (int w = 0; w < F.wave; ++w) { Min = fmaxf(Min, tot[8 + w] - Boff); Boff += tot[w]; }
    float* BC = (float*)(F.ws + WS_BC) + hh * SP; float* BW = (float*)(F.ws + WS_BW) + hh * SP; float* MR = (float*)(F.ws + WS_MR) + hh * SP;
    for (int it = 0; it < 16; ++it) { const int t = F.wave * 1024 + it * 64 + F.lane;
        const float B = Boff + sB[t], W = sW[t] - Boff, M = fmaxf(Min, sM[t] - Boff);
        BC[t] = B; BW[t] = W; MR[t] = M;
        if (t == SP - 1) F.out[O_MP + hh] = B + M; }
    __syncthreads();
}

__device__ __forceinline__ void attn_prompt_unit(const Frame& F, int qb, int g) {
    const bf16_t* P = (const bf16_t*)(F.ws + WS_P); const float* rope = (const float*)(F.ws + WS_ROPE);
    bf16_t* MIX = (bf16_t*)(F.ws + WS_MIX);
    LAS bf16_t* Ks = (LAS bf16_t*)F.lds;
    LAS bf16_t* Vt = Ks + 192 * 72;
    LAS bf16_t* Pw = Vt + 64 * 200 + F.wave * (16 * 200);
    const int q0 = qb * 64, lane = F.lane, fr = lane & 15, kg = lane >> 4, dgs = F.tid & 7;
    const int hq = g * 4 + (F.wave & 3), qh = F.wave >> 2;
    u32x4 qn0, qn1, qno; f32x4 qnc[4];
#define ATT_QLOAD(qtx) do { const int trx = q0 + qh * 32 + (qtx) * 16 + fr; const bf16_t* rowx = P + (size_t)trx * NIN + C_AQ + hq * 64; qn0 = *(const u32x4*)(rowx + kg * 8); qn1 = *(const u32x4*)(rowx + 32 + kg * 8); \
        if (kg < 2) { qno = *(const u32x4*)(rowx + (kg ^ 1) * 8); _Pragma("unroll") for (int k = 0; k < 4; ++k) qnc[k] = *(const f32x4*)(rope + (size_t)trx * 16 + 4 * k); } } while (0)
    ATT_QLOAD(0);
    u32x4 kv[3], ov[3], vv[2][2]; f32x4 kc[3][4];
#pragma unroll
    for (int it = 0; it < 3; ++it) { const int key = (it * 512 + F.tid) >> 3, kp = q0 - 128 + key; kv[it] = *(const u32x4*)(P + (size_t)(kp < 0 ? 0 : kp) * NIN + C_AK + g * 64 + dgs * 8); }
    if (dgs < 2) {
#pragma unroll
        for (int it = 0; it < 3; ++it) { const int key = (it * 512 + F.tid) >> 3, kp = q0 - 128 + key, kpc = kp < 0 ? 0 : kp; ov[it] = *(const u32x4*)(P + (size_t)kpc * NIN + C_AK + g * 64 + (dgs ^ 1) * 8);
#pragma unroll
            for (int k = 0; k < 4; ++k) kc[it][k] = *(const f32x4*)(rope + (size_t)kpc * 16 + 4 * k); } }
#pragma unroll
    for (int it = 0; it < 2; ++it) { const int item = it * 512 + F.tid; const int k2 = item < 768 ? item % 96 : 0, dg = item < 768 ? item / 96 : 0, kp = q0 - 128 + 2 * k2;
        const bf16_t* row = P + (size_t)(kp < 0 ? 0 : kp) * NIN + C_AV + g * 64 + dg * 8; vv[it][0] = *(const u32x4*)row; vv[it][1] = *(const u32x4*)(row + NIN); }
#pragma unroll
    for (int it = 0; it < 3; ++it) { const int key = (it * 512 + F.tid) >> 3, kp = q0 - 128 + key; u32x4 k4 = kv[it];
        if (dgs < 2) { float a[8], b[8]; unpack8(k4, a); unpack8(ov[it], b);
#pragma unroll
            for (int i = 0; i < 8; ++i) { const float cs = kc[it][i >> 2][i & 3], sn = kc[it][2 + (i >> 2)][i & 3]; a[i] = (dgs == 0) ? a[i] * cs - b[i] * sn : a[i] * cs + b[i] * sn; }
            k4 = pack8(a); }
        if (kp < 0) k4 = (u32x4){0u, 0u, 0u, 0u};
        *(LAS u32x4*)(Ks + key * 72 + dgs * 8) = k4; }
#pragma unroll
    for (int it = 0; it < 2; ++it) { const int item = it * 512 + F.tid; if (item < 768) { const int k2 = item % 96, dg = item / 96, kp = q0 - 128 + 2 * k2;
        u32x4 v0 = vv[it][0], v1 = vv[it][1]; if (kp < 0) { v0 = (u32x4){0u, 0u, 0u, 0u}; v1 = v0; }
        unsigned w[8]; zip8(v0, v1, w);
#pragma unroll
        for (int i = 0; i < 8; ++i) *(LAS unsigned*)(Vt + (dg * 8 + i) * 200 + 2 * k2) = w[i]; } }
    __syncthreads();
    const float sink = F.in[17][hq];
    for (int qt = 0; qt < 2; ++qt) {
        const int tq = q0 + qh * 32 + qt * 16;
        bf16x8 qf[2];
        { u32x4 qv = qn0;
          if (kg < 2) { float a[8], b[8]; unpack8(qv, a); unpack8(qno, b);
#pragma unroll
              for (int i = 0; i < 8; ++i) { const float cs = qnc[i >> 2][i & 3], sn = qnc[2 + (i >> 2)][i & 3]; a[i] = (kg == 0) ? a[i] * cs - b[i] * sn : a[i] * cs + b[i] * sn; }
              qv = pack8(a); }
          qf[0] = __builtin_bit_cast(bf16x8, qv); qf[1] = __builtin_bit_cast(bf16x8, qn1); }
        if (qt == 0) ATT_QLOAD(1);
        f32x4 s[12];
#pragma unroll
        for (int kt = 0; kt < 12; ++kt) { s[kt] = (f32x4){0.f, 0.f, 0.f, 0.f};
#pragma unroll
            for (int ks = 0; ks < 2; ++ks) { const bf16x8 kf = *(const LAS bf16x8*)(Ks + (kt * 16 + fr) * 72 + ks * 32 + kg * 8);
                s[kt] = __builtin_amdgcn_mfma_f32_16x16x32_bf16(kf, qf[ks], s[kt], 0, 0, 0); } }
        const int qp = tq + fr; float m = sink;
#pragma unroll
        for (int kt = 0; kt < 12; ++kt)
#pragma unroll
            for (int j = 0; j < 4; ++j) { const int kp = q0 - 128 + kt * 16 + kg * 4 + j; const bool ok = (kp >= 0) && (kp <= qp) && (qp - kp < 128);
                const float v = ok ? s[kt][j] * 0.125f : -INFINITY; s[kt][j] = v; m = fmaxf(m, v); }
        m = fmaxf(m, __shfl_xor(m, 16)); m = fmaxf(m, __shfl_xor(m, 32));
        float sum = 0.f;
        asm volatile("" ::: "memory");
#pragma unroll
        for (int kt = 0; kt < 12; ++kt) {
#pragma unroll
            for (int j = 0; j < 4; ++j) { const float p = __expf(s[kt][j] - m); s[kt][j] = p; sum += p; }
            u32x2 pk; pk.x = cvt_pk_bf16(s[kt][0], s[kt][1]); pk.y = cvt_pk_bf16(s[kt][2], s[kt][3]);
            *(LAS u32x2*)(Pw + fr * 200 + kt * 16 + kg * 4) = pk; }
        asm volatile("" ::: "memory");
        sum += __shfl_xor(sum, 16); sum += __shfl_xor(sum, 32);
        const float linv = 1.f / (sum + __expf(sink - m));
        f32x4 o[4];
#pragma unroll
        for (int dt = 0; dt < 4; ++dt) o[dt] = (f32x4){0.f, 0.f, 0.f, 0.f};
#pragma unroll
        for (int kk = 0; kk < 6; ++kk) { const bf16x8 pf = *(const LAS bf16x8*)(Pw + fr * 200 + kk * 32 + kg * 8);
#pragma unroll
            for (int dt = 0; dt < 4; ++dt) { const bf16x8 vf = *(const LAS bf16x8*)(Vt + (dt * 16 + fr) * 200 + kk * 32 + kg * 8);
                o[dt] = __builtin_amdgcn_mfma_f32_16x16x32_bf16(vf, pf, o[dt], 0, 0, 0); } }
        { bf16_t* op = MIX + (size_t)(tq + fr) * D + hq * 64 + kg * 4;
#pragma unroll
          for (int dt = 0; dt < 4; ++dt) { u32x2 pk; pk.x = cvt_pk_bf16(o[dt][0] * linv, o[dt][1] * linv); pk.y = cvt_pk_bf16(o[dt][2] * linv, o[dt][3] * linv); *(u32x2*)(op + dt * 16) = pk; } }
    }
    __syncthreads();
}

#undef ATT_QLOAD
__device__ __forceinline__ void attn_sample_wave(const Frame& F, int unit) {
    const bf16_t* P = (const bf16_t*)(F.ws + WS_P); const float* rope = (const float*)(F.ws + WS_ROPE);
    bf16_t* MIX = (bf16_t*)(F.ws + WS_MIX);
    const int b = unit >> 4, hq = unit & 15, g = hq >> 2, lane = F.lane;
    LAS float* base = (LAS float*)F.lds + F.wave * 1408;
    LAS float* sq = base; LAS float* sk = base + 256; LAS float* sv = base + 512; LAS float* sp = base + 768;
    float q4[4], k4[4], v4[4], qo4[4], ko4[4], c4[4], s4[4];
#pragma unroll
    for (int t = 0; t < 4; ++t) { const bf16_t* row = P + (size_t)(SP + b * 4 + t) * NIN; const float* cs = rope + (size_t)(SP + t) * 16;
        q4[t] = bf2f(row[C_AQ + hq * 64 + lane]); k4[t] = bf2f(row[C_AK + g * 64 + lane]); v4[t] = bf2f(row[C_AV + g * 64 + lane]);
        qo4[t] = bf2f(row[C_AQ + hq * 64 + ((lane ^ 8) & 15)]); ko4[t] = bf2f(row[C_AK + g * 64 + ((lane ^ 8) & 15)]); c4[t] = cs[lane & 7]; s4[t] = cs[8 + (lane & 7)]; }
#pragma unroll
    for (int t = 0; t < 4; ++t) { float qv = q4[t], kv = k4[t]; const float vv = v4[t];
        if (lane < 16) { const float c = c4[t], sn = s4[t]; if (lane < 8) { qv = qv * c - qo4[t] * sn; kv = kv * c - ko4[t] * sn; } else { qv = qv * c + qo4[t] * sn; kv = kv * c + ko4[t] * sn; } }
        sq[t * 64 + lane] = qv * 0.125f; sk[t * 64 + lane] = kv; sv[t * 64 + lane] = vv;
        if ((hq & 3) == 0) { F.out[O_KWS + ((size_t)b * 128 + 124 + t) * 256 + g * 64 + lane] = kv; F.out[O_VWS + ((size_t)b * 128 + 124 + t) * 256 + g * 64 + lane] = vv; } }
    const float sink = F.in[17][hq];
    float sc[3][4];
#pragma unroll
    for (int kk = 0; kk < 3; ++kk) { const int kidx = kk * 64 + lane;
#pragma unroll
        for (int t = 0; t < 4; ++t) sc[kk][t] = 0.f;
        if (kidx < 128) { const f32x4* kr = (const f32x4*)(F.in[2] + ((size_t)b * 128 + kidx) * 256 + g * 64);
#pragma unroll 8
            for (int d4 = 0; d4 < 16; ++d4) { const f32x4 kv = kr[d4];
#pragma unroll
                for (int t = 0; t < 4; ++t) { const f32x4 q = *(const LAS f32x4*)(sq + t * 64 + d4 * 4); sc[kk][t] += kv[0] * q[0] + kv[1] * q[1] + kv[2] * q[2] + kv[3] * q[3]; } } }
        else if (kidx < 132) { const int tn = kidx - 128;
#pragma unroll 4
            for (int d = 0; d < 64; ++d) { const float kv = sk[tn * 64 + d];
#pragma unroll
                for (int t = 0; t < 4; ++t) sc[kk][t] += kv * sq[t * 64 + d]; } }
#pragma unroll
        for (int t = 0; t < 4; ++t) { const bool ok = (kidx < 132) && (kidx > t) && (kidx <= t + 128); if (!ok) sc[kk][t] = -INFINITY; } }
    float linv[4];
#pragma unroll
    for (int t = 0; t < 4; ++t) { float m = fmaxf(fmaxf(sc[0][t], sc[1][t]), sc[2][t]); m = fmaxf(wave_max(m), sink);
        float sum = 0.f;
#pragma unroll
        for (int kk = 0; kk < 3; ++kk) { const float p = __expf(sc[kk][t] - m); sum += p; const int kidx = kk * 64 + lane; if (kidx < 160) sp[t * 160 + kidx] = p; }
        sum = wave_sum(sum) + __expf(sink - m); linv[t] = 1.f / sum; }
    const int kq = lane >> 4, dq = lane & 15;
    f32x4 o[4];
#pragma unroll
    for (int t = 0; t < 4; ++t) o[t] = (f32x4){0.f, 0.f, 0.f, 0.f};
    const float* vb = F.in[3] + ((size_t)b * 128 + kq) * 256 + g * 64 + dq * 4;
#pragma unroll 8
    for (int kb = 0; kb < 32; ++kb) { const f32x4 vv = *(const f32x4*)(vb + (size_t)kb * 1024);
#pragma unroll
        for (int t = 0; t < 4; ++t) o[t] += vv * sp[t * 160 + kb * 4 + kq]; }
    { const f32x4 vv = *(const LAS f32x4*)(sv + kq * 64 + dq * 4);
#pragma unroll
      for (int t = 0; t < 4; ++t) o[t] += vv * sp[t * 160 + 128 + kq]; }
#pragma unroll
    for (int t = 0; t < 4; ++t) {
#pragma unroll
        for (int e = 0; e < 4; ++e) { float v = o[t][e]; v += __shfl_xor(v, 16); v += __shfl_xor(v, 32); o[t][e] = v * linv[t]; }
        if (kq == t) { u32x2 pk; pk.x = cvt_pk_bf16(o[t][0], o[t][1]); pk.y = cvt_pk_bf16(o[t][2], o[t][3]); *(u32x2*)(MIX + (size_t)(SP + b * 4 + t) * D + hq * 64 + dq * 4) = pk; } }
}

__device__ __forceinline__ void mlstm_sample_unit(const Frame& F, int b, int h) {
    const bf16_t* P = (const bf16_t*)(F.ws + WS_P); const float* gates = (const float*)(F.ws + WS_GATES);
    bf16_t* MIX = (bf16_t*)(F.ws + WS_MIX);
    LAS float* sq = (LAS float*)F.lds; LAS float* sk = sq + 1024; LAS float* sv = sk + 1024; LAS float* sS = sv + 1024;
    const int tid = F.tid, lane = F.lane;
    const int bh = b * 4 + h;
    for (int i = tid; i < 1024; i += 512) { const int t = i >> 8, d = i & 255; const bf16_t* row = P + (size_t)(SP + b * 4 + t) * NIN;
        sq[i] = bf2f(row[C_MQ + h * 256 + d]) * 0.0625f; sk[i] = bf2f(row[C_MK + h * 256 + d]); sv[i] = bf2f(row[C_MV + h * 256 + d]); }
    if (tid < 64) sS[tid] = 0.f;
    __syncthreads();
    {
        const int pair = tid >> 5, sub = tid & 31, t = pair >> 2, s = pair & 3; float a = 0.f, c = 0.f;
#pragma unroll
        for (int e = 0; e < 8; ++e) { const int d = sub * 8 + e; a += sq[t * 256 + d] * sk[s * 256 + d]; if (s == 0) c += sq[t * 256 + d] * F.in[5][(size_t)bh * 256 + d]; }
#pragma unroll
        for (int o = 16; o >= 1; o >>= 1) { a += __shfl_xor(a, o); c += __shfl_xor(c, o); }
        if (sub == 0) { sS[pair] = a; if (s == 0) sS[16 + t] = c; } }
    __syncthreads();
    float li[4], bcum[4], mt[4], at[4], gs[4], sm[4][4], den[4];
    const float m0 = F.in[6][bh];
    { float acc = 0.f;
#pragma unroll
      for (int t = 0; t < 4; ++t) { const float* gp = gates + (size_t)(SP + b * 4 + t) * 8; li[t] = gp[h] + F.in[15][h]; acc += logsigmoid_fast(gp[4 + h] + F.in[16][h]); bcum[t] = acc; } }
#pragma unroll
    for (int t = 0; t < 4; ++t) { const float mi = bcum[t] + m0; float m = mi;
#pragma unroll
        for (int s = 0; s < 4; ++s) if (s <= t) m = fmaxf(m, bcum[t] - bcum[s] + li[s]);
        mt[t] = m; at[t] = __expf(mi - m); float dsum = at[t] * sS[16 + t];
#pragma unroll
        for (int s = 0; s < 4; ++s) { sm[t][s] = (s <= t) ? sS[t * 4 + s] * __expf(bcum[t] - bcum[s] + li[s] - m) : 0.f; dsum += sm[t][s]; }
        den[t] = fmaxf(fabsf(dsum), __expf(-m)); }
    const float mnew = mt[3], decay = __expf(bcum[3] + m0 - mnew);
#pragma unroll
    for (int s = 0; s < 4; ++s) gs[s] = __expf(bcum[3] - bcum[s] + li[s] - mnew);
    const int r8 = lane >> 3, seg = lane & 7, w = F.wave;
    const float* c0b = F.in[4] + (size_t)bh * 65536 + (size_t)(w * 32 + r8) * 256 + seg * 4;
    float* c1b = F.out + O_CS + (size_t)bh * 65536 + (size_t)(w * 32 + r8) * 256 + seg * 4;
    float acc[4][4], gv[4][4];
#pragma unroll
    for (int rg = 0; rg < 4; ++rg)
#pragma unroll
        for (int t = 0; t < 4; ++t) { acc[rg][t] = 0.f; gv[rg][t] = gs[t] * sv[t * 256 + w * 32 + rg * 8 + r8]; }
    if (tid == 0) {
#pragma unroll
        for (int t = 0; t < 4; ++t) { sS[40 + t] = at[t]; sS[44 + t] = den[t];
#pragma unroll
            for (int s2 = 0; s2 < 4; ++s2) sS[48 + t * 4 + s2] = sm[t][s2]; } }
    f32x4 c[2][2][4];
#pragma unroll
    for (int i2 = 0; i2 < 2; ++i2)
#pragma unroll
        for (int rg = 0; rg < 4; ++rg) c[0][i2][rg] = __builtin_nontemporal_load((const f32x4*)(c0b + rg * 2048 + i2 * 32));
#pragma unroll
    for (int hh = 0; hh < 4; ++hh) {
        if (hh < 3) {
#pragma unroll
            for (int i2 = 0; i2 < 2; ++i2)
#pragma unroll
                for (int rg = 0; rg < 4; ++rg) c[(hh + 1) & 1][i2][rg] = __builtin_nontemporal_load((const f32x4*)(c0b + rg * 2048 + ((hh + 1) * 2 + i2) * 32)); }
#pragma unroll
        for (int i2 = 0; i2 < 2; ++i2) { const int it = hh * 2 + i2; const int d = it * 32 + seg * 4;
            f32x4 q[4], k[4];
#pragma unroll
            for (int t = 0; t < 4; ++t) { q[t] = *(const LAS f32x4*)(sq + t * 256 + d); k[t] = *(const LAS f32x4*)(sk + t * 256 + d); }
#pragma unroll
            for (int rg = 0; rg < 4; ++rg) { const f32x4 cv = c[hh & 1][i2][rg]; f32x4 nv = cv * decay;
#pragma unroll
                for (int t = 0; t < 4; ++t) { acc[rg][t] += cv[0] * q[t][0] + cv[1] * q[t][1] + cv[2] * q[t][2] + cv[3] * q[t][3]; nv += k[t] * gv[rg][t]; }
                __builtin_nontemporal_store(nv, (f32x4*)(c1b + rg * 2048 + it * 32)); } }
    }
    __syncthreads();
    float hv[4][4], ssq[4] = {0.f, 0.f, 0.f, 0.f};
#pragma unroll
    for (int rg = 0; rg < 4; ++rg)
#pragma unroll
        for (int t = 0; t < 4; ++t) { float a = acc[rg][t]; a += __shfl_xor(a, 1); a += __shfl_xor(a, 2); a += __shfl_xor(a, 4);
            float num = sS[40 + t] * a;
#pragma unroll
            for (int s2 = 0; s2 < 4; ++s2) num += sS[48 + t * 4 + s2] * sv[s2 * 256 + w * 32 + rg * 8 + r8];
            hv[rg][t] = num / sS[44 + t]; if (seg == 0) ssq[t] += hv[rg][t] * hv[rg][t]; }
#pragma unroll
    for (int t = 0; t < 4; ++t) { ssq[t] = wave_sum(ssq[t]); }
    if (lane == 0) {
#pragma unroll
        for (int t = 0; t < 4; ++t) lds_add(&sS[32 + t], ssq[t]); }
    if (tid < 256) { float nn = decay * F.in[5][(size_t)bh * 256 + tid];
#pragma unroll
        for (int s2 = 0; s2 < 4; ++s2) nn += gs[s2] * sk[s2 * 256 + tid];
        F.out[O_NS + (size_t)bh * 256 + tid] = nn; }
    if (tid == 0) F.out[O_MS + bh] = mnew;
    __syncthreads();
#pragma unroll
    for (int rg = 0; rg < 4; ++rg)
#pragma unroll
        for (int t = 0; t < 4; ++t) if (seg == ((rg * 4 + t) & 7)) { const int vr = w * 32 + rg * 8 + r8; const size_t row = (size_t)(SP + b * 4 + t);
            const float rms = rsqrtf(sS[32 + t] * (1.f / 256.f) + EPS); const float og = sigmoidf_(bf2f(P[row * NIN + C_MO + h * 256 + vr]));
            MIX[row * D + 1024 + h * 256 + vr] = (bf16_t)(cvt_pk_bf16(hv[rg][t] * rms * F.in[18][h * 256 + vr] * og, 0.f) & 0xffff); }
    __syncthreads();
}

__device__ __forceinline__ void mlstm_u_unit(const Frame& F, int c, int h, int vh) {
    const bf16_t* P = (const bf16_t*)(F.ws + WS_P);
    const float* BW = (const float*)(F.ws + WS_BW) + h * SP; const float* MR = (const float*)(F.ws + WS_MR) + h * SP;
    LAS bf16_t* VtS = (LAS bf16_t*)F.lds;
    LAS bf16_t* KtS = VtS + 128 * 72;
    LAS float* gS = (LAS float*)(KtS + 256 * 72);
    const int lane = F.lane, fr = lane & 15, kg = lane >> 4, w = F.wave;
    const float mend = MR[c * LC + LC - 1];
    f32x4 acc[4][4];
#pragma unroll
    for (int a = 0; a < 4; ++a)
#pragma unroll
        for (int b = 0; b < 4; ++b) acc[a][b] = (f32x4){0.f, 0.f, 0.f, 0.f};
    float un = 0.f;
    u32x4 vr0, vr1, kr[2][2]; float bw0, bw1, bwg;
#define D1_LOAD(sbx) do { const int s0x = c * LC + (sbx) * 64; { const int s2 = F.tid & 31, vg = F.tid >> 5; bw0 = BW[s0x + 2 * s2]; bw1 = BW[s0x + 2 * s2 + 1]; bwg = BW[s0x + (F.tid & 63)]; \
            const bf16_t* src = P + (size_t)(s0x + 2 * s2) * NIN + C_MV + h * 256 + vh * 128 + vg * 8; vr0 = *(const u32x4*)src; vr1 = *(const u32x4*)(src + NIN); } \
        _Pragma("unroll") for (int it = 0; it < 2; ++it) { const int item = it * 512 + F.tid, s2 = item & 31, dg = item >> 5; const bf16_t* src = P + (size_t)(s0x + 2 * s2) * NIN + C_MK + h * 256 + dg * 8; \
            kr[it][0] = *(const u32x4*)src; kr[it][1] = *(const u32x4*)(src + NIN); } } while (0)
    D1_LOAD(0);
    for (int sb = 0; sb < LC / 64; ++sb) {
        if (F.tid < 64) gS[F.tid] = __expf(bwg - mend);
        { const int s2 = F.tid & 31, vg = F.tid >> 5; const float g0 = __expf(bw0 - mend), g1 = __expf(bw1 - mend);
            float f0[8], f1[8]; unpack8(vr0, f0); unpack8(vr1, f1);
#pragma unroll
            for (int i = 0; i < 8; ++i) *(LAS unsigned*)(VtS + (vg * 8 + i) * 72 + 2 * s2) = cvt_pk_bf16(f0[i] * g0, f1[i] * g1); }
#pragma unroll
        for (int it = 0; it < 2; ++it) { const int item = it * 512 + F.tid, s2 = item & 31, dg = item >> 5;
            unsigned wd[8]; zip8(kr[it][0], kr[it][1], wd);
#pragma unroll
            for (int i = 0; i < 8; ++i) *(LAS unsigned*)(KtS + (dg * 8 + i) * 72 + 2 * s2) = wd[i]; }
        if (sb + 1 < LC / 64) D1_LOAD(sb + 1);
        __syncthreads();
#pragma unroll
        for (int ks = 0; ks < 2; ++ks) { bf16x8 vf[4];
#pragma unroll
            for (int vt = 0; vt < 4; ++vt) vf[vt] = *(const LAS bf16x8*)(VtS + ((w & 1) * 64 + vt * 16 + fr) * 72 + ks * 32 + kg * 8);
#pragma unroll
            for (int dt = 0; dt < 4; ++dt) { const bf16x8 kf = *(const LAS bf16x8*)(KtS + ((w >> 1) * 64 + dt * 16 + fr) * 72 + ks * 32 + kg * 8);
#pragma unroll
                for (int vt = 0; vt < 4; ++vt) acc[dt][vt] = __builtin_amdgcn_mfma_f32_16x16x32_bf16(kf, vf[vt], acc[dt][vt], 0, 0, 0); } }
        if (vh == 0 && F.tid < 256) {
#pragma unroll
            for (int j8 = 0; j8 < 8; ++j8) { float kf[8]; unpack8(*(const LAS u32x4*)(KtS + F.tid * 72 + j8 * 8), kf); const f32x4 ga = *(const LAS f32x4*)(gS + j8 * 8), gb = *(const LAS f32x4*)(gS + j8 * 8 + 4);
                un += ga[0] * kf[0] + ga[1] * kf[1] + ga[2] * kf[2] + ga[3] * kf[3] + gb[0] * kf[4] + gb[1] * kf[5] + gb[2] * kf[6] + gb[3] * kf[7]; } }
        __syncthreads(); }
    float* U = (float*)(F.ws + WS_U) + ((size_t)(c * 4 + h) * 256) * 256;
#pragma unroll
    for (int dt = 0; dt < 4; ++dt)
#pragma unroll
        for (int vt = 0; vt < 4; ++vt) { const int v = vh * 128 + (w & 1) * 64 + vt * 16 + fr, d = (w >> 1) * 64 + dt * 16 + kg * 4; *(f32x4*)(U + (size_t)v * 256 + d) = acc[dt][vt]; }
    if (vh == 0 && F.tid < 256) ((float*)(F.ws + WS_UN))[(c * 4 + h) * 256 + F.tid] = un;
}

#undef D1_LOAD
__device__ __forceinline__ void mlstm_state_scan(const Frame& F) {
    const float* MRb = (const float*)(F.ws + WS_MR);
    const float* U = (const float*)(F.ws + WS_U); bf16_t* CST = (bf16_t*)(F.ws + WS_CST);
    LAS float* sdec = (LAS float*)F.lds;
    if (F.tid < 128) { const int h = F.tid >> 5, c = F.tid & 31; const float* MR = MRb + h * SP; sdec[F.tid] = expf((c == 0 ? 0.f : MR[c * LC - 1]) - MR[c * LC + LC - 1]); }
    __syncthreads();
    const int gt = F.bid * 512 + F.tid, GT = F.G * 512;
    typedef float f32x2 __attribute__((ext_vector_type(2)));
    for (int e2 = gt; e2 < 131072; e2 += GT) { const int h = e2 >> 15;
        f32x2 C = (f32x2){0.f, 0.f};
#pragma unroll 1
        for (int c0 = 0; c0 < NCH; c0 += 8) { f32x2 u[8];
#pragma unroll
            for (int k = 0; k < 8; ++k) u[k] = *(const f32x2*)(U + (size_t)(c0 + k) * 262144 + (size_t)e2 * 2);
#pragma unroll
            for (int k = 0; k < 8; ++k) { *(unsigned*)(CST + (size_t)(c0 + k) * 262144 + (size_t)e2 * 2) = cvt_pk_bf16(C[0], C[1]); C = C * sdec[h * 32 + c0 + k] + u[k]; } }
        *(f32x2*)(F.out + O_CP + (size_t)e2 * 2) = C; }
    for (int e = gt; e < 1024; e += GT) { const int h = e >> 8; const float* UN = (const float*)(F.ws + WS_UN); float* NST = (float*)(F.ws + WS_NST);
        float n = 0.f;
        for (int c = 0; c < NCH; ++c) { NST[c * 1024 + e] = n; n = n * sdec[h * 32 + c] + UN[c * 1024 + e]; }
        F.out[O_NP + e] = n; }
    __syncthreads();
}

__device__ __forceinline__ void mlstm_out_unit(const Frame& F, int c, int h, int tb) {
    const bf16_t* P = (const bf16_t*)(F.ws + WS_P); bf16_t* MIX = (bf16_t*)(F.ws + WS_MIX);
    const float* BC = (const float*)(F.ws + WS_BC) + h * SP; const float* BW = (const float*)(F.ws + WS_BW) + h * SP; const float* MR = (const float*)(F.ws + WS_MR) + h * SP;
    const bf16_t* CST = (const bf16_t*)(F.ws + WS_CST) + (size_t)(c * 4 + h) * 65536; const float* NST = (const float*)(F.ws + WS_NST) + (c * 4 + h) * 256;
    LAS bf16_t* Qs = (LAS bf16_t*)F.lds;
    LAS bf16_t* Ks = Qs + 64 * 264;
    LAS bf16_t* VtS = Ks + 64 * 264;
    LAS bf16_t* Ps = VtS + 256 * 72;
    LAS float* sA = (LAS float*)(Ps + 64 * 72);
    LAS float* sDen = sA + 64;
    LAS float* sMr = sDen + 64;
    LAS float* sSq = sMr + 64;
    const int tid = F.tid, lane = F.lane, fr = lane & 15, kg = lane >> 4, w = F.wave;
    const int t0 = c * LC + tb * 64;
    const float mstart = c == 0 ? 0.f : MR[c * LC - 1];
#pragma unroll
    for (int it = 0; it < 4; ++it) { const int item = it * 512 + tid, t = item >> 5, dg = item & 31;
        *(LAS u32x4*)(Qs + t * 264 + dg * 8) = *(const u32x4*)(P + (size_t)(t0 + t) * NIN + C_MQ + h * 256 + dg * 8); }
    u32x4 kreg[4], vreg[2][2];
#define P6_LOAD(sbx) do { const int s0x = c * LC + (sbx) * 64; _Pragma("unroll") for (int it = 0; it < 4; ++it) { const int item = it * 512 + tid, sx = item >> 5, dg = item & 31; \
            kreg[it] = *(const u32x4*)(P + (size_t)(s0x + sx) * NIN + C_MK + h * 256 + dg * 8); } \
        _Pragma("unroll") for (int it = 0; it < 2; ++it) { const int item = it * 512 + tid, s2 = item & 31, vg = item >> 5; const bf16_t* src = P + (size_t)(s0x + 2 * s2) * NIN + C_MV + h * 256 + vg * 8; \
            vreg[it][0] = *(const u32x4*)src; vreg[it][1] = *(const u32x4*)(src + NIN); } } while (0)
    P6_LOAD(0);
    if (tid < 64) { const float mr = MR[t0 + tid]; sMr[tid] = mr; sA[tid] = expf(mstart - mr) * 0.0625f; sSq[tid] = 0.f; }
    __syncthreads();
    {
        const int t = tid >> 3, sub = tid & 7; float a = 0.f; f32x4 nv[8];
#pragma unroll
        for (int e4 = 0; e4 < 8; ++e4) nv[e4] = *(const f32x4*)(NST + sub * 32 + e4 * 4);
#pragma unroll
        for (int e4 = 0; e4 < 8; ++e4) { const u32x2 qq = *(const LAS u32x2*)(Qs + t * 264 + sub * 32 + e4 * 4);
            a += bf_lo(qq.x) * nv[e4][0] + bf_hi(qq.x) * nv[e4][1] + bf_lo(qq.y) * nv[e4][2] + bf_hi(qq.y) * nv[e4][3]; }
        a += __shfl_xor(a, 1); a += __shfl_xor(a, 2); a += __shfl_xor(a, 4);
        if (sub == 0) sDen[t] = a * sA[t]; }
    f32x4 acc[4][2];
#pragma unroll
    for (int a = 0; a < 4; ++a) { acc[a][0] = (f32x4){0.f, 0.f, 0.f, 0.f}; acc[a][1] = acc[a][0]; }
    { bf16x8 cf[8][2];
#pragma unroll
      for (int ks = 0; ks < 8; ++ks)
#pragma unroll
          for (int vt = 0; vt < 2; ++vt) cf[ks][vt] = __builtin_bit_cast(bf16x8, *(const u32x4*)(CST + (size_t)(w * 32 + vt * 16 + fr) * 256 + ks * 32 + kg * 8));
#pragma unroll
      for (int ks = 0; ks < 8; ++ks)
#pragma unroll
          for (int tt = 0; tt < 4; ++tt) { const bf16x8 qf = *(const LAS bf16x8*)(Qs + (tt * 16 + fr) * 264 + ks * 32 + kg * 8);
#pragma unroll
              for (int vt = 0; vt < 2; ++vt) acc[tt][vt] = __builtin_amdgcn_mfma_f32_16x16x32_bf16(cf[ks][vt], qf, acc[tt][vt], 0, 0, 0); } }
#pragma unroll
    for (int tt = 0; tt < 4; ++tt) { const float a = sA[tt * 16 + fr]; acc[tt][0] *= a; acc[tt][1] *= a; }
    __syncthreads();
    for (int sb = 0; sb <= tb; ++sb) { const int s0 = c * LC + sb * 64;
#pragma unroll
        for (int it = 0; it < 4; ++it) { const int item = it * 512 + tid, sx = item >> 5, dg = item & 31; *(LAS u32x4*)(Ks + sx * 264 + dg * 8) = kreg[it]; }
#pragma unroll
        for (int it = 0; it < 2; ++it) { const int item = it * 512 + tid, s2 = item & 31, vg = item >> 5;
            unsigned wd[8]; zip8(vreg[it][0], vreg[it][1], wd);
#pragma unroll
            for (int i = 0; i < 8; ++i) *(LAS unsigned*)(VtS + (vg * 8 + i) * 72 + 2 * s2) = wd[i]; }
        if (sb < tb) P6_LOAD(sb + 1);
        __syncthreads();
        {
            const int tt = w >> 1; f32x4 sacc[2]; sacc[0] = (f32x4){0.f, 0.f, 0.f, 0.f}; sacc[1] = sacc[0];
#pragma unroll 2
            for (int ks = 0; ks < 8; ++ks) { const bf16x8 qf = *(const LAS bf16x8*)(Qs + (tt * 16 + fr) * 264 + ks * 32 + kg * 8);
#pragma unroll
                for (int x = 0; x < 2; ++x) { const bf16x8 kf = *(const LAS bf16x8*)(Ks + (((w & 1) * 2 + x) * 16 + fr) * 264 + ks * 32 + kg * 8);
                    sacc[x] = __builtin_amdgcn_mfma_f32_16x16x32_bf16(qf, kf, sacc[x], 0, 0, 0); } }
            float rs[4] = {0.f, 0.f, 0.f, 0.f};
#pragma unroll
            for (int x = 0; x < 2; ++x) { const int sl = ((w & 1) * 2 + x) * 16 + fr; const float ws = BW[s0 + sl];
#pragma unroll
                for (int j = 0; j < 4; ++j) { const int tl = tt * 16 + kg * 4 + j; const bool ok = (s0 + sl) <= (t0 + tl);
                    const float pv = ok ? sacc[x][j] * 0.0625f * expf(ws - sMr[tl]) : 0.f; rs[j] += pv;
                    Ps[tl * 72 + sl] = (bf16_t)(cvt_pk_bf16(pv, 0.f) & 0xffff); } }
#pragma unroll
            for (int j = 0; j < 4; ++j) { float r = rs[j]; r += __shfl_xor(r, 1); r += __shfl_xor(r, 2); r += __shfl_xor(r, 4); r += __shfl_xor(r, 8);
                if (fr == 0) lds_add(&sDen[tt * 16 + kg * 4 + j], r); } }
        __syncthreads();
#pragma unroll
        for (int ks = 0; ks < 2; ++ks) { bf16x8 vf[2];
#pragma unroll
            for (int vt = 0; vt < 2; ++vt) vf[vt] = *(const LAS bf16x8*)(VtS + (w * 32 + vt * 16 + fr) * 72 + ks * 32 + kg * 8);
#pragma unroll
            for (int tt = 0; tt < 4; ++tt) { const bf16x8 pf = *(const LAS bf16x8*)(Ps + (tt * 16 + fr) * 72 + ks * 32 + kg * 8);
#pragma unroll
                for (int vt = 0; vt < 2; ++vt) acc[tt][vt] = __builtin_amdgcn_mfma_f32_16x16x32_bf16(vf[vt], pf, acc[tt][vt], 0, 0, 0); } }
        __syncthreads(); }
#pragma unroll
    for (int tt = 0; tt < 4; ++tt) { const int tl = tt * 16 + fr; const float mt = BC[t0 + tl] + sMr[tl]; const float dn = 1.f / fmaxf(fabsf(sDen[tl]), expf(-mt));
        acc[tt][0] *= dn; acc[tt][1] *= dn; float q = 0.f;
#pragma unroll
        for (int j = 0; j < 4; ++j) q += acc[tt][0][j] * acc[tt][0][j] + acc[tt][1][j] * acc[tt][1][j];
        q += __shfl_xor(q, 16); q += __shfl_xor(q, 32);
        if (kg == 0) lds_add(&sSq[tl], q); }
    __syncthreads();
    {
        u32x2 ogp[4][2]; f32x4 nwv[2];
#pragma unroll
        for (int vt = 0; vt < 2; ++vt) nwv[vt] = *(const f32x4*)(F.in[18] + h * 256 + w * 32 + vt * 16 + kg * 4);
#pragma unroll
        for (int tt = 0; tt < 4; ++tt)
#pragma unroll
            for (int vt = 0; vt < 2; ++vt) ogp[tt][vt] = *(const u32x2*)(P + (size_t)(t0 + tt * 16 + fr) * NIN + C_MO + h * 256 + w * 32 + vt * 16 + kg * 4);
#pragma unroll
        for (int tt = 0; tt < 4; ++tt) { const int tl = tt * 16 + fr; const float rms = rsqrtf(sSq[tl] * (1.f / 256.f) + EPS); bf16_t* op = MIX + (size_t)(t0 + tl) * D + 1024 + h * 256 + w * 32 + kg * 4;
#pragma unroll
            for (int vt = 0; vt < 2; ++vt) { const u32x2 og = ogp[tt][vt]; const f32x4 a4 = acc[tt][vt] * rms * nwv[vt];
                u32x2 pk; pk.x = cvt_pk_bf16(a4[0] * sigmoidf_(bf_lo(og.x)), a4[1] * sigmoidf_(bf_hi(og.x))); pk.y = cvt_pk_bf16(a4[2] * sigmoidf_(bf_lo(og.y)), a4[3] * sigmoidf_(bf_hi(og.y)));
                *(u32x2*)(op + vt * 16) = pk; } } }
    __syncthreads();
}

#undef P6_LOAD
__device__ __forceinline__ void final_norm_phase(const Frame& F, int rlo) {
    const float* nw = F.in[11];
    for (int r = rlo + F.bid * 8 + F.wave; r < MTOT; r += F.G * 8) { f32x4* xr = (f32x4*)(F.out + (size_t)r * D);
        const f32x4* sr = r < SP ? xr : (const f32x4*)(F.ws + WS_X1) + (size_t)r * (D / 4);
        f32x4 xv[8]; float ss = 0.f;
#pragma unroll
        for (int i = 0; i < 8; ++i) xv[i] = sr[i * 64 + F.lane];
        if (r >= SP) { for (int z = 0; z < 11; ++z) { const f32x4* pp = (const f32x4*)(F.ws + WS_PART) + ((size_t)z * MS + (r - SP)) * (D / 4);
#pragma unroll
                for (int i = 0; i < 8; ++i) xv[i] += pp[i * 64 + F.lane]; } }
#pragma unroll
        for (int i = 0; i < 8; ++i) ss += xv[i][0] * xv[i][0] + xv[i][1] * xv[i][1] + xv[i][2] * xv[i][2] + xv[i][3] * xv[i][3];
        ss = wave_sum(ss); const float rstd = rsqrtf(ss * (1.f / D) + EPS);
#pragma unroll
        for (int i = 0; i < 8; ++i) { const f32x4 w = ((const f32x4*)nw)[i * 64 + F.lane]; xr[i * 64 + F.lane] = xv[i] * rstd * w; } }
}

__global__ void __launch_bounds__(512, 2) fwd_mega(Params prm) {
    extern __shared__ __attribute__((aligned(16))) unsigned char lds_raw[];
    cg::grid_group grid = cg::this_grid();
    Frame F;
    F.lds = (LAS unsigned char*)lds_raw; F.tid = threadIdx.x; F.lane = F.tid & 63; F.wave = __builtin_amdgcn_readfirstlane(F.tid >> 6); F.G = gridDim.x; F.bid = blockIdx.x;
#pragma unroll
    for (int i = 0; i < 23; ++i) F.in[i] = prm.in[i];
    F.out = prm.out; F.ws = prm.ws;
    unsigned char* ws = F.ws;
    const int lo = prm.ph_lo, hi = prm.ph_hi;
#ifndef PH_MASK
#define PH_MASK 0xfff
#endif
#define IN(k) (((PH_MASK >> (k)) & 1) && lo <= (k) && (k) < hi)
#define SEAM(k) do { if (IN(k) && IN((k) + 1)) { if ((k) == 0) grid.sync(); else xcd_barrier(xbar); } } while (0)
#ifndef REPMASK
#define REPMASK 0
#endif
#define REPS(k) for (int rep_ = 0; rep_ < 1 + ((REPMASK >> (k)) & 1); ++rep_, (((REPMASK >> (k)) & 1) && rep_ == 1 ? grid.sync() : (void)0))
    const float* mod = (const float*)(ws + WS_MOD);
    volatile LAS unsigned* xst = (volatile LAS unsigned*)(F.lds + LDS_BYTES - 16);
    if (F.tid == 0) { xst[0] = 0u; xst[1] = 0u; }
    __syncthreads();
    XcdBarrier xbar; xbar.bar = (unsigned*)(ws + WS_BAR); xbar.x = 0; xbar.st = xst;
    if (hi - lo > 1) xbar = xcd_barrier_post((unsigned*)(ws + WS_BAR), xst);

    if (IN(0)) REPS(0) p0_prologue(F);
    SEAM(0);
    if (IN(1)) { { const int cb = F.G > 96 ? 48 : 0;
          if (F.bid >= cb) convert_tiles(F, 1536, 4608, F.bid - cb, F.G - cb); }
        pg8::Gemm g{(const bf16_t*)(ws + WS_SILU), (const bf16_t*)(ws + WS_WADA), D, D}; pg8::SplitKOrder S{48, 1, F.G, F.bid, 32};
        pg8::EpiMod E{(float*)(ws + WS_MOD), F.in[13]}; pg8::gemm_phase(F.lds, g, S, E); }
    SEAM(1);
    if (IN(2)) REPS(2) norm_mod_phase<true>(F, F.in[0], F.in[1], F.in[9], 0, 2048, 0, nullptr);
    SEAM(2);
    if (IN(3)) REPS(3) {
        if (F.bid >= F.G - 4) mlstm_scan(F, F.bid - (F.G - 4));
        pg8::Gemm g{(const bf16_t*)(ws + WS_H), (const bf16_t*)(ws + WS_WIN), D, D}; pg8::StaticOrder S; S.init(MTOT, NIN, F.G, F.bid, D / 64);
        pg8::EpiBf16 E{(bf16_t*)(ws + WS_P), NIN}; pg8::gemm_phase(F.lds, g, S, E); }
    SEAM(3);
    if (IN(4)) REPS(4) {
        const bool cfirst = (F.bid & 1) != 0;
        if (cfirst && (prm.p4m & 2)) for (int u = F.bid; u < 512; u += F.G) mlstm_sample_unit(F, u >> 2, u & 3);
        if (prm.p4m & 1) for (int u = F.bid; u < 256; u += F.G) mlstm_u_unit(F, u >> 3, (u >> 1) & 3, u & 1);
        if (prm.p4m & 4) for (int u = F.bid; u < 512; u += F.G) attn_prompt_unit(F, u >> 2, u & 3);
        if (prm.p4m & 8) for (int rep = 0; rep < ((prm.p4m & 16) ? 2 : 1); ++rep) for (int u = F.bid * 8 + F.wave; u < 2048; u += F.G * 8) attn_sample_wave(F, u);
        if (!cfirst && (prm.p4m & 2)) for (int u = F.bid; u < 512; u += F.G) mlstm_sample_unit(F, u >> 2, u & 3);
        { const bf16_t* P = (const bf16_t*)(ws + WS_P); const float* rope = (const float*)(ws + WS_ROPE);
          for (int i = F.bid * 512 + F.tid; i < 32768; i += F.G * 512) { const int pos = SP - 128 + (i >> 8), cc = i & 255, d = cc & 63; const bf16_t* row = P + (size_t)pos * NIN;
              float kv = bf2f(row[C_AK + cc]);
              if (d < 16) { const float ko = bf2f(row[C_AK + (cc ^ 8)]); const float cs = rope[pos * 16 + (d & 7)], sn = rope[pos * 16 + 8 + (d & 7)]; kv = d < 8 ? kv * cs - ko * sn : kv * cs + ko * sn; }
              F.out[O_KWP + i] = kv; F.out[O_VWP + i] = bf2f(row[C_AV + cc]); } }
    }
    SEAM(4);
    if (IN(5)) REPS(5) mlstm_state_scan(F);
    SEAM(5);
    if (IN(6)) REPS(6) { for (int u = F.bid; u < 512; u += F.G) { const int tb = u < 256 ? 3 - (u >> 7) : ((u - 256) >> 7); const int ch = u & 127; mlstm_out_unit(F, ch >> 2, ch & 3, tb); } }
    SEAM(6);
    if (IN(7)) REPS(7) { pg8::Gemm g{(const bf16_t*)(ws + WS_MIX), (const bf16_t*)(ws + WS_WOUT), D, D}; pg8::PromptSampleOrder S{F.G, F.bid, D / 64, 4};
        pg8::EpiRes E{(float*)(ws + WS_X1), F.in[0], F.in[1], mod + 4096, (float*)(ws + WS_PART)}; pg8::gemm_phase(F.lds, g, S, E);
        if (F.G == 256) { if (F.bid >= 64) kvwin_copy(F, (F.bid - 64) * 512 + F.tid, (F.G - 64) * 512); } else kvwin_copy(F, F.bid * 512 + F.tid, F.G * 512); }
    SEAM(7);
    if (IN(8)) REPS(8) { float* x1 = (float*)(ws + WS_X1); norm_mod_phase<false>(F, x1, F.in[1], F.in[10], 3 * 2048, 4 * 2048, 4, x1 + (size_t)SP * D); }
    SEAM(8);
    if (IN(9)) REPS(9) { pg8::Gemm g{(const bf16_t*)(ws + WS_H), (const bf16_t*)(ws + WS_WGU), D, D}; pg8::StaticOrder S; S.init(MTOT, 2 * DFF, F.G, F.bid, D / 64);
        pg8::EpiGU E{(bf16_t*)(ws + WS_P), DFF}; pg8::gemm_phase(F.lds, g, S, E); }
    SEAM(9);
    if (IN(10)) REPS(10) { const float* x1 = (const float*)(ws + WS_X1); pg8::Gemm g{(const bf16_t*)(ws + WS_P), (const bf16_t*)(ws + WS_WDN), DFF, DFF}; pg8::PromptSampleOrder S{F.G, F.bid, DFF / 64, 11};
        if (F.G == 256) { pg8::EpiResNorm E{F.out + O_Y, x1, mod + 5 * 2048, (float*)(ws + WS_PART), F.in[11], (float*)(ws + WS_SSQ), (unsigned*)(ws + WS_PCNT), (LAS float*)(F.lds + 131072)}; pg8::gemm_phase(F.lds, g, S, E); }
        else { pg8::EpiRes E{F.out + O_Y, x1, x1 + (size_t)SP * D, mod + 5 * 2048, (float*)(ws + WS_PART)}; pg8::gemm_phase(F.lds, g, S, E); } }
    SEAM(10);
    if (IN(11)) final_norm_phase(F, F.G == 256 ? SP : 0);
#undef IN
#undef SEAM
}

#ifndef MK_MULTI
#define MK_MULTI 0
#endif

extern "C" void kernel_launch(void* const* d_in, const int* in_sizes, int n_in, void* d_out, int out_size, void* d_ws, size_t ws_size, hipStream_t stream) {
    static int grid = 0;
    if (grid == 0) {
        if (n_in != 23 || (size_t)out_size != O_END || ws_size < WS_END) { fprintf(stderr, "kernel_launch: unexpected sizes: n_in %d out %d (want %zu) ws %zu (want >= %zu)\n", n_in, out_size, (size_t)O_END, ws_size, (size_t)WS_END); grid = -1; return; }
        int dev = 0, cus = 0, per_cu = 0;
        (void)hipGetDevice(&dev); (void)hipDeviceGetAttribute(&cus, hipDeviceAttributeMultiprocessorCount, dev);
        if (hipFuncSetAttribute((const void*)fwd_mega, hipFuncAttributeMaxDynamicSharedMemorySize, LDS_BYTES) != hipSuccess) { fprintf(stderr, "kernel_launch: hipFuncSetAttribute failed\n"); grid = -1; return; }
        if (hipOccupancyMaxActiveBlocksPerMultiprocessor(&per_cu, (const void*)fwd_mega, 512, LDS_BYTES) != hipSuccess || per_cu < 1) { fprintf(stderr, "kernel_launch: occupancy query says %d blocks/CU\n", per_cu); per_cu = 1; }
        (void)hipGetLastError();
        grid = cus * 1;
        fprintf(stderr, "kernel_launch: cus %d per_cu %d grid %d ws %zu need %zu\n", cus, per_cu, grid, ws_size, (size_t)WS_END);
    }
    if (grid < 0) return;
    Params p{};
    for (int i = 0; i < 23; ++i) p.in[i] = (const float*)d_in[i];
    p.out = (float*)d_out; p.ws = (unsigned char*)d_ws; p.p4m = 15;
#if MK_MULTI
#ifndef DUPMASK
#define DUPMASK 0
#endif
#ifndef DUP_P4M
#define DUP_P4M 15
#endif
    for (int ph = 0; ph < NPHASE; ++ph) for (int r = 0; r < 1 + ((DUPMASK >> ph) & 1); ++r) { p.ph_lo = ph; p.ph_hi = ph + 1; p.p4m = (r == 1 && ph == 4) ? DUP_P4M : 15; hipLaunchKernelGGL(fwd_mega, dim3(grid), dim3(512), LDS_BYTES, stream, p); }
#else
    p.ph_lo = 0; p.ph_hi = NPHASE;
    (void)hipMemsetAsync((unsigned char*)d_ws + WS_BAR, 0, 16384, stream);
    void* args[] = {&p};
    hipError_t e = hipLaunchCooperativeKernel((const void*)fwd_mega, dim3(grid), dim3(512), args, LDS_BYTES, stream);
    if (e != hipSuccess) fprintf(stderr, "cooperative launch failed: %s (grid %d)\n", hipGetErrorString(e), grid);
#endif
}
```
